# Optimizing an MI355X kernel written in HIP

```python
import jax, jax.numpy as jnp
from jax import lax
import numpy as np

D_MODEL = 2048
BATCH = 16
SEQ = 2048
DEPTH = 1
DEC_BATCH = 32
DEC_SEQ = 8
PAST_LEN = 16384
PAGE_SIZE = 128

D_PLE = 256
D_FF = 5632
POOL_WIDTH = 1024
POOL_WINDOWS = (2, 4, 8, 16)
POOL_GROUPS = len(POOL_WINDOWS)
POOL_GROUP_WIDTH = POOL_WIDTH // POOL_GROUPS
POOL_STATE = max(POOL_WINDOWS) - 1
HEAD_DIM = 128
HEADS_PER_GROUP = 8
ATTN_GROUPS = ((128, 1), (512, 4), (2048, 16))
N_ATTN_GROUPS = len(ATTN_GROUPS)
ATTN_HEADS = N_ATTN_GROUPS * HEADS_PER_GROUP
QKV_WIDTH = ATTN_HEADS * HEAD_DIM
ATTN_OUT_WIDTH = HEADS_PER_GROUP * HEAD_DIM
BAND_BLOCK = 128
IN_WIDTH = POOL_WIDTH + 3 * QKV_WIDTH + 2 * D_MODEL
RMS_EPS = 1e-6
NEG_INF = -1e30

kernel_name = "hybrid_pool_dilated_attn_macaron_decoder_step"


def rmsnorm(x, g):
    x32 = x.astype(jnp.float32)
    y = x32 * lax.rsqrt(jnp.mean(x32 * x32, axis=-1, keepdims=True) + RMS_EPS) * g.astype(jnp.float32)
    return y.astype(x.dtype)


def swiglu(x, w_in, w_out):
    a, b = jnp.split(x @ w_in, 2, axis=-1)
    return (jax.nn.silu(a) * b) @ w_out


def alibi_slopes():
    j = jnp.arange(1, HEADS_PER_GROUP + 1, dtype=jnp.float32)
    return jnp.exp2(-8.0 * j / HEADS_PER_GROUP)


def causal_multiscale_pool(z, prev, pos0):
    B, T, P = z.shape
    ext = jnp.concatenate([prev, z], axis=1)
    ext32 = ext.astype(jnp.float32)
    cs = jnp.concatenate([jnp.zeros((B, 1, P), jnp.float32), jnp.cumsum(ext32, axis=1)], axis=1)
    S = POOL_STATE
    pos = pos0 + jnp.arange(T)
    outs = []
    for gi, w in enumerate(POOL_WINDOWS):
        sl = slice(gi * POOL_GROUP_WIDTH, (gi + 1) * POOL_GROUP_WIDTH)
        wsum = cs[:, S + 1:S + 1 + T, sl] - cs[:, S + 1 - w:S + 1 - w + T, sl]
        cnt = jnp.minimum(w, pos + 1).astype(jnp.float32)
        outs.append(wsum / cnt[None, :, None] - ext32[:, S:, sl])
    return jnp.stack(outs, axis=2), ext


def dilated_band_attn(q, k, v, dil, n_steps, slopes):
    B, T, H, hd = q.shape
    M = T // dil
    C = BAND_BLOCK
    nb = -(-M // C)
    Mp = nb * C

    def to_res(a):
        return a.reshape(B, M, dil, H, hd).transpose(0, 2, 1, 3, 4)

    qr, kr, vr = to_res(q), to_res(k), to_res(v)
    qb = jnp.pad(qr, ((0, 0), (0, 0), (0, Mp - M), (0, 0), (0, 0))).reshape(B, dil, nb, C, H, hd)
    kp = jnp.pad(kr, ((0, 0), (0, 0), (C, Mp - M), (0, 0), (0, 0))).reshape(B, dil, nb + 1, C, H, hd)
    vp = jnp.pad(vr, ((0, 0), (0, 0), (C, Mp - M), (0, 0), (0, 0))).reshape(B, dil, nb + 1, C, H, hd)
    kwin = jnp.concatenate([kp[:, :, :-1], kp[:, :, 1:]], axis=3)
    vwin = jnp.concatenate([vp[:, :, :-1], vp[:, :, 1:]], axis=3)
    s = jnp.einsum('bgnqhd,bgnkhd->bgnhqk', qb.astype(jnp.float32), kwin.astype(jnp.float32)) * (HEAD_DIM ** -0.5)
    iq = jnp.arange(C)[:, None]
    jk = jnp.arange(2 * C)[None, :]
    steps = C + iq - jk
    m_k = jnp.arange(nb)[:, None, None] * C - C + jk[None]
    valid = (steps >= 0) & (steps <= n_steps) & (m_k >= 0)
    bias = -slopes[:, None, None] * (steps * dil).astype(jnp.float32)[None]
    logits = jnp.where(valid[None, None, :, None], s + bias[None, None, None], NEG_INF)
    mx = jnp.max(logits, axis=-1, keepdims=True)
    p = jnp.exp(logits - mx)
    den = jnp.sum(p, axis=-1, keepdims=True)
    o = jnp.einsum('bgnhqk,bgnkhd->bgnqhd', p, vwin.astype(jnp.float32))
    o = o / jnp.swapaxes(den[..., 0], 3, 4)[..., None]
    lse = jnp.swapaxes((mx + jnp.log(den))[..., 0], 3, 4)
    o = o.reshape(B, dil, Mp, H, hd)[:, :, :M].transpose(0, 2, 1, 3, 4).reshape(B, T, H, hd)
    lse = lse.reshape(B, dil, Mp, H)[:, :, :M].transpose(0, 2, 1, 3).reshape(B, T, H)
    return o, lse


def dilated_gather_attn(q, k_ext, v_ext, dil, n_steps, slopes):
    B, T, H, hd = q.shape
    L = k_ext.shape[1] - T
    j = jnp.arange(n_steps + 1)
    idx = L + jnp.arange(T)[:, None] - j[None, :] * dil
    valid = idx >= 0
    idx_c = jnp.maximum(idx, 0)
    kg = jnp.take(k_ext, idx_c, axis=1).astype(jnp.float32)
    vg = jnp.take(v_ext, idx_c, axis=1).astype(jnp.float32)
    s = jnp.einsum('bthd,btjhd->bthj', q.astype(jnp.float32), kg) * (HEAD_DIM ** -0.5)
    bias = -slopes[:, None] * (j * dil).astype(jnp.float32)[None, :]
    logits = jnp.where(valid[None, :, None, :], s + bias[None, None], NEG_INF)
    mx = jnp.max(logits, axis=-1, keepdims=True)
    p = jnp.exp(logits - mx)
    den = jnp.sum(p, axis=-1, keepdims=True)
    o = jnp.einsum('bthj,btjhd->bthd', p, vg) / den
    lse = (mx + jnp.log(den))[..., 0]
    return o, lse


def layer(x, p, pool_prev, kv_prev, pos0, ffn1_norm, ffn1_w_in, ffn1_w_out, mix_norm, w_in, q_norm, k_norm,
          pool_map, pool_scale, w_pool_out, w_attn_out, w_out, ffn2_norm, ffn2_w_in, ffn2_w_out,
          ple_norm, ple_gate, ple_proj):
    B, T, _ = x.shape
    h = x + 0.5 * swiglu(rmsnorm(x, ffn1_norm), ffn1_w_in, ffn1_w_out)
    u = rmsnorm(h, mix_norm)
    i1 = POOL_WIDTH
    i2 = i1 + QKV_WIDTH
    i3 = i2 + QKV_WIDTH
    i4 = i3 + QKV_WIDTH
    z, q, k, v, gates = jnp.split(u @ w_in, [i1, i2, i3, i4], axis=-1)
    pooled, pool_ext = causal_multiscale_pool(z, pool_prev, pos0)
    y_pool = jnp.einsum('btgc,gcd->btgd', pooled.astype(x.dtype), pool_map).reshape(B, T, POOL_WIDTH) * pool_scale
    a_pool = y_pool @ w_pool_out
    q = rmsnorm(q.reshape(B, T, N_ATTN_GROUPS, HEADS_PER_GROUP, HEAD_DIM), q_norm)
    k = rmsnorm(k.reshape(B, T, N_ATTN_GROUPS, HEADS_PER_GROUP, HEAD_DIM), k_norm)
    v = v.reshape(B, T, N_ATTN_GROUPS, HEADS_PER_GROUP, HEAD_DIM)
    slopes = alibi_slopes()
    outs, lses, new_kv = [], [], []
    for g, (window, dil) in enumerate(ATTN_GROUPS):
        n_steps = window // dil
        qg, kg, vg = q[:, :, g], k[:, :, g], v[:, :, g]
        if kv_prev is None:
            o, lse = dilated_band_attn(qg, kg, vg, dil, n_steps, slopes)
            keep = min(window, T)
            new_kv += [kg[:, T - keep:], vg[:, T - keep:]]
        else:
            k_ext = jnp.concatenate([kv_prev[2 * g], kg], axis=1)
            v_ext = jnp.concatenate([kv_prev[2 * g + 1], vg], axis=1)
            o, lse = dilated_gather_attn(qg, k_ext, v_ext, dil, n_steps, slopes)
            keep = min(window, k_ext.shape[1])
            new_kv += [k_ext[:, k_ext.shape[1] - keep:], v_ext[:, v_ext.shape[1] - keep:]]
        outs.append(o)
        lses.append(lse)
    wts = jax.nn.softmax(jnp.stack(lses), axis=0)
    o_attn = jnp.einsum('gbth,gbthd->bthd', wts, jnp.stack(outs)).reshape(B, T, ATTN_OUT_WIDTH).astype(x.dtype)
    a_attn = o_attn @ w_attn_out
    g_pool, g_attn = jnp.split(jax.nn.sigmoid(gates), 2, axis=-1)
    h = h + (g_pool * a_pool + g_attn * a_attn) @ w_out
    h = h + 0.5 * swiglu(rmsnorm(h, ffn2_norm), ffn2_w_in, ffn2_w_out)
    h = h + jax.nn.sigmoid(rmsnorm(h, ple_norm) @ ple_gate) * (p @ ple_proj)
    new_pool = pool_ext[:, pool_ext.shape[1] - POOL_STATE:]
    return h, new_pool, new_kv


def setup_inputs(seed: int = 0) -> dict:
    key = jax.random.key(seed)
    ks = iter(jax.random.split(key, 48))

    def nrm(shape, scale=1.0):
        return scale * jax.random.normal(next(ks), shape, jnp.float32)

    def gain(shape):
        return 1.0 + 0.1 * jax.random.normal(next(ks), shape, jnp.float32)

    d = {}
    d["x_prompt"] = nrm((BATCH, SEQ, D_MODEL))
    d["x_sample"] = nrm((DEC_BATCH, DEC_SEQ, D_MODEL))
    d["p_prompt"] = nrm((DEPTH, BATCH, SEQ, D_PLE))
    d["p_sample"] = nrm((DEPTH, DEC_BATCH, DEC_SEQ, D_PLE))
    d["state_pool"] = nrm((DEPTH, DEC_BATCH, POOL_STATE, POOL_WIDTH))
    for g, (window, _) in enumerate(ATTN_GROUPS):
        L = min(window, PAST_LEN)
        d["cache_k%d" % g] = nrm((DEPTH, DEC_BATCH, L, HEADS_PER_GROUP, HEAD_DIM))
        d["cache_v%d" % g] = nrm((DEPTH, DEC_BATCH, L, HEADS_PER_GROUP, HEAD_DIM))
    d["ffn1_norm"] = gain((DEPTH, D_MODEL))
    d["ffn1_w_in"] = nrm((DEPTH, D_MODEL, 2 * D_FF), D_MODEL ** -0.5)
    d["ffn1_w_out"] = nrm((DEPTH, D_FF, D_MODEL), D_FF ** -0.5)
    d["mix_norm"] = gain((DEPTH, D_MODEL))
    d["w_in"] = nrm((DEPTH, D_MODEL, IN_WIDTH), D_MODEL ** -0.5)
    d["q_norm"] = gain((DEPTH, HEAD_DIM))
    d["k_norm"] = gain((DEPTH, HEAD_DIM))
    d["pool_map"] = nrm((DEPTH, POOL_GROUPS, POOL_GROUP_WIDTH, POOL_GROUP_WIDTH), POOL_GROUP_WIDTH ** -0.5)
    d["pool_scale"] = gain((DEPTH, POOL_WIDTH))
    d["w_pool_out"] = nrm((DEPTH, POOL_WIDTH, D_MODEL), POOL_WIDTH ** -0.5)
    d["w_attn_out"] = nrm((DEPTH, ATTN_OUT_WIDTH, D_MODEL), ATTN_OUT_WIDTH ** -0.5)
    d["w_out"] = nrm((DEPTH, D_MODEL, D_MODEL), D_MODEL ** -0.5)
    d["ffn2_norm"] = gain((DEPTH, D_MODEL))
    d["ffn2_w_in"] = nrm((DEPTH, D_MODEL, 2 * D_FF), D_MODEL ** -0.5)
    d["ffn2_w_out"] = nrm((DEPTH, D_FF, D_MODEL), D_FF ** -0.5)
    d["ple_norm"] = gain((DEPTH, D_MODEL))
    d["ple_gate"] = nrm((DEPTH, D_MODEL, D_MODEL), D_MODEL ** -0.5)
    d["ple_proj"] = nrm((DEPTH, D_PLE, D_MODEL), D_PLE ** -0.5)
    return d


def reference(x_prompt, x_sample, p_prompt, p_sample, state_pool, cache_k0, cache_v0, cache_k1, cache_v1,
              cache_k2, cache_v2, ffn1_norm, ffn1_w_in, ffn1_w_out, mix_norm, w_in, q_norm, k_norm, pool_map,
              pool_scale, w_pool_out, w_attn_out, w_out, ffn2_norm, ffn2_w_in, ffn2_w_out, ple_norm, ple_gate,
              ple_proj):
    caches = (cache_k0, cache_v0, cache_k1, cache_v1, cache_k2, cache_v2)
    hp, hs = x_prompt, x_sample
    pool_p_rows, pool_s_rows, kv_p_rows, kv_s_rows = [], [], [], []
    for i in range(DEPTH):
        w = (ffn1_norm[i], ffn1_w_in[i], ffn1_w_out[i], mix_norm[i], w_in[i], q_norm[i], k_norm[i], pool_map[i],
             pool_scale[i], w_pool_out[i], w_attn_out[i], w_out[i], ffn2_norm[i], ffn2_w_in[i], ffn2_w_out[i],
             ple_norm[i], ple_gate[i], ple_proj[i])
        zeros_prev = jnp.zeros((hp.shape[0], POOL_STATE, POOL_WIDTH), hp.dtype)
        hp, pp, kvp = layer(hp, p_prompt[i], zeros_prev, None, 0, *w)
        hs, ps, kvs = layer(hs, p_sample[i], state_pool[i], tuple(c[i] for c in caches), PAST_LEN, *w)
        pool_p_rows.append(pp)
        pool_s_rows.append(ps)
        kv_p_rows.append(kvp)
        kv_s_rows.append(kvs)
    pool_p = jnp.stack(pool_p_rows)
    pool_s = jnp.stack(pool_s_rows)
    kp = [jnp.stack([r[j] for r in kv_p_rows]) for j in range(2 * N_ATTN_GROUPS)]
    kvs_ = [jnp.stack([r[j] for r in kv_s_rows]) for j in range(2 * N_ATTN_GROUPS)]
    return (hp, hs, pool_p, kp[0], kp[1], kp[2], kp[3], kp[4], kp[5],
            pool_s, kvs_[0], kvs_[1], kvs_[2], kvs_[3], kvs_[4], kvs_[5])
```

```cpp
#include <hip/hip_runtime.h>
#include <cstdio>
#include <cstdint>

#ifndef MK_N_LAUNCHES
#define MK_N_LAUNCHES 1
#endif

namespace pg8 {
#define PG8_LAS __attribute__((address_space(3)))
typedef unsigned short bf16_t;
typedef short bf16x8 __attribute__((ext_vector_type(8)));
typedef float f32x4 __attribute__((ext_vector_type(4)));
typedef unsigned u32x4 __attribute__((ext_vector_type(4)));
typedef unsigned u32x2 __attribute__((ext_vector_type(2)));
constexpr int BM = 256, BK = 64, HALF = 128, HTB = HALF * BK * 2, STAGE_BYTES = 8 * HTB, NXCD = 8, WGM = 8;

__host__ __device__ __forceinline__ int lds_byte(int r, int c) { const int st = (r >> 4) * 2 + (c >> 5), rr = r & 15, cc = c & 31, ob = rr * 64 + cc * 2; return st * 1024 + (ob ^ (((ob >> 9) & 1) << 5)); }
__host__ __device__ __forceinline__ void stage_rc(int b, int& R, int& C) { const int st = b / 1024, sb = b % 1024, swz = sb ^ (((sb >> 9) & 1) << 5); R = (st >> 1) * 16 + swz / 64; C = (st & 1) * 32 + (swz % 64) / 2; }
__host__ __device__ __forceinline__ int perm32(int rho) { const int n = rho >> 4, i = rho & 15; return 8 * (i >> 2) + 4 * n + (i & 3); }

struct Unit { int pm, pn; };
struct Gemm { const bf16_t* A; const bf16_t* Bt; int M, N, K, lda, ldb, a_pn_off; };

struct StaticOrder {
    int nM, nN, nwg, G, c;
    __host__ __device__ void init(int M, int N, int G_, int c_) { nM = M / BM; nN = N / BM; nwg = nM * nN; G = G_; c = c_; }
    __host__ __device__ bool next(int i, Unit& u) const {
        const long L = (long)i * G + c; if (L >= nwg) return false;
        int wgid = (int)L; { const int q = nwg / NXCD, r = nwg % NXCD, xcd = wgid % NXCD, off = wgid / NXCD; wgid = (xcd < r ? xcd * (q + 1) : r * (q + 1) + (xcd - r) * q) + off; }
        const int nig = WGM * nN, gid = wgid / nig, fm = gid * WGM, gsz = (nM - fm) < WGM ? (nM - fm) : WGM;
        u.pm = fm + ((wgid % nig) % gsz); u.pn = (wgid % nig) / gsz; return true;
    }
    __device__ __forceinline__ void a_ready(const Unit&) const {}
    __device__ __forceinline__ void done(const Unit&) const {}
};

__device__ __forceinline__ unsigned cvt_pk_bf16(float lo, float hi) { unsigned r; asm volatile("v_cvt_pk_bf16_f32 %0, %1, %2" : "=v"(r) : "v"(lo), "v"(hi)); return r; }
__device__ __forceinline__ float bf_lo(unsigned w) { return __uint_as_float(w << 16); }
__device__ __forceinline__ float bf_hi(unsigned w) { return __uint_as_float(w & 0xffff0000u); }
__device__ __forceinline__ u32x4 pack8(const f32x4& v0, const f32x4& v1) { u32x4 w; w.x = cvt_pk_bf16(v0[0], v0[1]); w.y = cvt_pk_bf16(v0[2], v0[3]); w.z = cvt_pk_bf16(v1[0], v1[1]); w.w = cvt_pk_bf16(v1[2], v1[3]); return w; }
__device__ __forceinline__ void unpack8(const u32x4& w, f32x4& v0, f32x4& v1) { v0 = (f32x4){bf_lo(w.x), bf_hi(w.x), bf_lo(w.y), bf_hi(w.y)}; v1 = (f32x4){bf_lo(w.z), bf_hi(w.z), bf_lo(w.w), bf_hi(w.w)}; }
__device__ __forceinline__ float sigmoidf_(float x) { return __builtin_amdgcn_rcpf(1.0f + __builtin_amdgcn_exp2f(-1.4426950408889634f * x)); }

template <class Epi, class Sched, bool ALIGN_EPI = true, bool SP2 = true>
__device__ __forceinline__ void gemm_phase(PG8_LAS unsigned char* lds, const Gemm g, const Sched& S, const Epi& E) {
    int tid_ = threadIdx.x; asm volatile("" : "+v"(tid_));
    const int tid = tid_, wid = __builtin_amdgcn_readfirstlane(tid >> 6), lane = tid & 63, wr = wid >> 2, wc = wid & 3, fr = lane & 15, fq = lane >> 4;
    int K_ = g.K; asm volatile("" : "+s"(K_));
    const int K = K_, nt = K / BK;
    unsigned voffA[2], voffB[2];
#pragma unroll
    for (int i = 0; i < 2; ++i) { int R, C; stage_rc(tid * 16 + i * 8192, R, C); const int Rb = Epi::PERM ? ((R & ~31) + perm32(R & 31)) : R;
        voffA[i] = (unsigned)(R * g.lda + C) * 2u; voffB[i] = (unsigned)(Rb * g.ldb + C) * 2u; }
    const unsigned kstep = (unsigned)(BK * 2);
    const unsigned hstepA = (unsigned)HALF * g.lda * 2, hstepB = (unsigned)HALF * g.ldb * 2;
    const unsigned tstepA = 2 * hstepA, tstepB = 2 * hstepB;
    const unsigned ldsw = (unsigned)wid * 1024u;
    const int aoff = lds_byte(wr * 64 + fr, fq * 8), boff = lds_byte(wc * 32 + fr, fq * 8);
#define PG8_SA(b, h) (((b) * 2 + (h)) * HTB)
#define PG8_SB(b, h) ((4 + (b) * 2 + (h)) * HTB)
#define PG8_STAGE(bufoff, gbase, voff) do { _Pragma("unroll") for (int _i = 0; _i < 2; ++_i) \
        __builtin_amdgcn_global_load_lds((const unsigned*)((const char*)(gbase) + (voff)[_i]), (PG8_LAS unsigned*)(lds + (bufoff) + ldsw + _i * 8192), 16, 0, 0); } while (0)
#define PG8_LDA(dst, b, h) do { _Pragma("unroll") for (int m = 0; m < 4; ++m) _Pragma("unroll") for (int k = 0; k < 2; ++k) dst[m][k] = *(const PG8_LAS bf16x8*)(lds + PG8_SA(b, h) + aoff + m * 2048 + k * 1024); } while (0)
#define PG8_LDB(dst, b, h) do { _Pragma("unroll") for (int n = 0; n < 2; ++n) _Pragma("unroll") for (int k = 0; k < 2; ++k) dst[n][k] = *(const PG8_LAS bf16x8*)(lds + PG8_SB(b, h) + boff + n * 2048 + k * 1024); } while (0)
#define PG8_MMA(ai, bj, At, Bt) do { __builtin_amdgcn_s_setprio(1); _Pragma("unroll") for (int m = 0; m < 4; ++m) _Pragma("unroll") for (int n = 0; n < 2; ++n) _Pragma("unroll") for (int k = 0; k < 2; ++k) \
        acc[ai][bj][m][n] = __builtin_amdgcn_mfma_f32_16x16x32_bf16(Bt[n][k], At[m][k], acc[ai][bj][m][n], 0, 0, 0); __builtin_amdgcn_s_setprio(0); } while (0)
#define PG8_WAIT_V(n) asm volatile("s_waitcnt vmcnt(" #n ")" ::: "memory")
#define PG8_WAIT_L(n) asm volatile("s_waitcnt lgkmcnt(" #n ")" ::: "memory")
#define PG8_BAR __builtin_amdgcn_s_barrier()
#define PG8_SCHED __builtin_amdgcn_sched_barrier(0)
    Unit cur, nxt; int ui = 0;
    if (!S.next(0, cur)) return;
    f32x4 acc[2][2][4][2];
#pragma unroll
    for (int a = 0; a < 2; ++a)
#pragma unroll
        for (int b = 0; b < 2; ++b)
#pragma unroll
            for (int m = 0; m < 4; ++m)
#pragma unroll
                for (int n = 0; n < 2; ++n) acc[a][b][m][n] = (f32x4){0.f, 0.f, 0.f, 0.f};
    bf16x8 At[4][2], B0[2][2], B1[2][2];
    const char* cA = (const char*)g.A + (size_t)cur.pm * tstepA + (size_t)cur.pn * g.a_pn_off * 2; const char* cB = (const char*)g.Bt + (size_t)cur.pn * tstepB;
    S.a_ready(cur);
    if constexpr (SP2) {
        PG8_STAGE(PG8_SB(0, 0), cB, voffB); PG8_STAGE(PG8_SB(0, 1), cB + hstepB, voffB); PG8_STAGE(PG8_SA(0, 0), cA, voffA); PG8_STAGE(PG8_SA(0, 1), cA + hstepA, voffA);
        if (wr == 1) PG8_BAR;
        PG8_WAIT_V(2); PG8_BAR;
        PG8_STAGE(PG8_SB(1, 0), cB + kstep, voffB); PG8_STAGE(PG8_SA(1, 0), cA + kstep, voffA); PG8_STAGE(PG8_SB(1, 1), cB + hstepB + kstep, voffB);
        PG8_WAIT_V(6); PG8_BAR;
    } else {
        PG8_STAGE(PG8_SB(0, 0), cB, voffB); PG8_STAGE(PG8_SA(0, 0), cA, voffA); PG8_STAGE(PG8_SB(0, 1), cB + hstepB, voffB); PG8_STAGE(PG8_SA(0, 1), cA + hstepA, voffA);
        if (wr == 1) PG8_BAR;
        PG8_WAIT_V(4); PG8_BAR;
        PG8_STAGE(PG8_SB(1, 0), cB + kstep, voffB); PG8_STAGE(PG8_SA(1, 0), cA + kstep, voffA); PG8_STAGE(PG8_SB(1, 1), cB + hstepB + kstep, voffB);
        PG8_WAIT_V(6); PG8_BAR;
    }
    for (;;) {
        const bool has_next = S.next(ui + 1, nxt);
        const char* nA = has_next ? (const char*)g.A + (size_t)nxt.pm * tstepA + (size_t)nxt.pn * g.a_pn_off * 2 : cA; const char* nB = has_next ? (const char*)g.Bt + (size_t)nxt.pn * tstepB : cB;
        for (int t = 0; t < nt; t += 2) {
            const bool last = (t == nt - 2);
            const char* a1 = cA + (size_t)(t + 1) * kstep;
            const char* a2 = last ? nA : cA + (size_t)(t + 2) * kstep; const char* b2 = last ? nB : cB + (size_t)(t + 2) * kstep;
            const char* a3 = a2 + kstep; const char* b3 = b2 + kstep;
            if (last && has_next) S.a_ready(nxt);
            if constexpr (SP2) {
            PG8_LDB(B0, 0, 0); PG8_LDB(B1, 0, 1); PG8_SCHED; PG8_LDA(At, 0, 0); PG8_STAGE(PG8_SA(1, 1), a1 + hstepA, voffA);
            PG8_WAIT_V(8); PG8_WAIT_L(0); PG8_BAR; PG8_MMA(0, 0, At, B0); PG8_MMA(0, 1, At, B1); PG8_BAR; PG8_SCHED;
            PG8_LDA(At, 0, 1); PG8_STAGE(PG8_SB(0, 0), b2, voffB); PG8_STAGE(PG8_SB(0, 1), b2 + hstepB, voffB); PG8_STAGE(PG8_SA(0, 0), a2, voffA);
            PG8_WAIT_V(8); PG8_WAIT_L(0); PG8_BAR; PG8_MMA(1, 0, At, B0); PG8_MMA(1, 1, At, B1); PG8_BAR; PG8_SCHED;
            PG8_LDB(B0, 1, 0); PG8_LDB(B1, 1, 1); PG8_SCHED; PG8_LDA(At, 1, 0); PG8_STAGE(PG8_SA(0, 1), a2 + hstepA, voffA);
            PG8_WAIT_V(8); PG8_WAIT_L(0); PG8_BAR; PG8_MMA(0, 0, At, B0); PG8_MMA(0, 1, At, B1); PG8_BAR; PG8_SCHED;
            PG8_LDA(At, 1, 1); PG8_STAGE(PG8_SB(1, 0), b3, voffB); PG8_STAGE(PG8_SB(1, 1), b3 + hstepB, voffB); PG8_STAGE(PG8_SA(1, 0), a3, voffA);
            PG8_WAIT_V(8); PG8_WAIT_L(0); PG8_BAR; PG8_MMA(1, 0, At, B0); PG8_MMA(1, 1, At, B1); PG8_BAR; PG8_SCHED;
            } else {
            PG8_LDB(B0, 0, 0); PG8_SCHED; PG8_LDA(At, 0, 0); PG8_STAGE(PG8_SA(1, 1), a1 + hstepA, voffA);
            PG8_WAIT_L(8); PG8_BAR; PG8_WAIT_L(0); PG8_MMA(0, 0, At, B0); PG8_BAR; PG8_SCHED;
            PG8_LDB(B1, 0, 1); PG8_STAGE(PG8_SB(0, 0), b2, voffB);
            PG8_BAR; PG8_WAIT_L(0); PG8_MMA(0, 1, At, B1); PG8_BAR;
            PG8_LDA(At, 0, 1); PG8_STAGE(PG8_SA(0, 0), a2, voffA);
            PG8_BAR; PG8_WAIT_L(0); PG8_MMA(1, 0, At, B0); PG8_BAR; PG8_SCHED;
            PG8_STAGE(PG8_SB(0, 1), b2 + hstepB, voffB);
            PG8_WAIT_V(6); PG8_BAR; PG8_MMA(1, 1, At, B1); PG8_BAR;
            PG8_LDB(B0, 1, 0); PG8_SCHED; PG8_LDA(At, 1, 0); PG8_STAGE(PG8_SA(0, 1), a2 + hstepA, voffA);
            PG8_WAIT_L(8); PG8_BAR; PG8_WAIT_L(0); PG8_MMA(0, 0, At, B0); PG8_BAR; PG8_SCHED;
            PG8_LDB(B1, 1, 1); PG8_STAGE(PG8_SB(1, 0), b3, voffB);
            PG8_BAR; PG8_WAIT_L(0); PG8_MMA(0, 1, At, B1); PG8_BAR;
            PG8_LDA(At, 1, 1); PG8_STAGE(PG8_SA(1, 0), a3, voffA);
            PG8_BAR; PG8_WAIT_L(0); PG8_MMA(1, 0, At, B0); PG8_BAR; PG8_SCHED;
            PG8_STAGE(PG8_SB(1, 1), b3 + hstepB, voffB);
            PG8_WAIT_V(6); PG8_BAR; PG8_MMA(1, 1, At, B1); PG8_BAR;
            }
        }
        if constexpr (ALIGN_EPI) { if (wr == 0) PG8_BAR; }
        E(acc, cur, wr, wc, fr, fq);
        if (!has_next) break;
#pragma unroll
        for (int a = 0; a < 2; ++a)
#pragma unroll
            for (int b = 0; b < 2; ++b)
#pragma unroll
                for (int m = 0; m < 4; ++m)
#pragma unroll
                    for (int n = 0; n < 2; ++n) acc[a][b][m][n] = (f32x4){0.f, 0.f, 0.f, 0.f};
        cur = nxt; cA = nA; cB = nB; ++ui;
        if constexpr (ALIGN_EPI) { if (wr == 1) PG8_BAR; }
    }
    PG8_WAIT_V(0);
    if constexpr (!ALIGN_EPI) { if (wr == 0) PG8_BAR; }
    PG8_BAR;
#undef PG8_SA
#undef PG8_SB
#undef PG8_STAGE
#undef PG8_LDA
#undef PG8_LDB
#undef PG8_MMA
#undef PG8_WAIT_V
#undef PG8_WAIT_L
#undef PG8_BAR
#undef PG8_SCHED
}
}

constexpr int NWAVES = 8;
constexpr int D = 2048, FF = 5632, PW = 1024, QKVW = 3072, INW = 14336, DPLE = 256, HD = 128;
constexpr int NB_P = 16, T_P = 2048, NB_S = 32, T_S = 8;
constexpr int MP = NB_P * T_P, MS = NB_S * T_S, M = MP + MS;
constexpr float RMS_EPS = 1e-6f;
static_assert(M % 256 == 0, "M");

constexpr size_t O_Y = 0;
constexpr size_t O_SPP = (size_t)M * D;
constexpr size_t O_K0P = O_SPP + (size_t)16 * 15 * 1024;
constexpr size_t O_V0P = O_K0P + (size_t)16 * 128 * 1024;
constexpr size_t O_K1P = O_V0P + (size_t)16 * 128 * 1024;
constexpr size_t O_V1P = O_K1P + (size_t)16 * 512 * 1024;
constexpr size_t O_K2P = O_V1P + (size_t)16 * 512 * 1024;
constexpr size_t O_V2P = O_K2P + (size_t)16 * 2048 * 1024;
constexpr size_t O_SPS = O_V2P + (size_t)16 * 2048 * 1024;
constexpr size_t O_K0S = O_SPS + (size_t)32 * 15 * 1024;
constexpr size_t O_V0S = O_K0S + (size_t)32 * 128 * 1024;
constexpr size_t O_K1S = O_V0S + (size_t)32 * 128 * 1024;
constexpr size_t O_V1S = O_K1S + (size_t)32 * 512 * 1024;
constexpr size_t O_K2S = O_V1S + (size_t)32 * 512 * 1024;
constexpr size_t O_V2S = O_K2S + (size_t)32 * 2048 * 1024;
constexpr size_t O_END = O_V2S + (size_t)32 * 2048 * 1024;
static_assert(O_END == 332611584ull, "d_out size");

constexpr size_t MiB = 1u << 20;
constexpr size_t WS_CTL = 0, CTL_ZERO_BYTES = 1 * MiB;
constexpr size_t WS_SS0 = 1 * MiB;
constexpr size_t WS_LSE = 2 * MiB;
constexpr size_t WS_W1T = 8 * MiB;
constexpr size_t WS_W2T = WS_W1T + 44 * MiB;
constexpr size_t WS_WINT = WS_W2T + 22 * MiB;
constexpr size_t WS_PMT = WS_WINT + 56 * MiB;
constexpr size_t WS_WPOT = WS_PMT + 1 * MiB;
constexpr size_t WS_WAOT = WS_WPOT + 4 * MiB;
constexpr size_t WS_WOT = WS_WAOT + 4 * MiB;
constexpr size_t WS_W3T = WS_WOT + 8 * MiB;
constexpr size_t WS_W4T = WS_W3T + 44 * MiB;
constexpr size_t WS_PGT = WS_W4T + 22 * MiB;
constexpr size_t WS_PPT = WS_PGT + 8 * MiB;
constexpr size_t WS_PB = WS_PPT + 1 * MiB;
constexpr size_t WS_XB = WS_PB + 17 * MiB;
constexpr size_t WS_ZB = WS_XB + 129 * MiB;
constexpr size_t WS_QB = WS_ZB + 65 * MiB;
constexpr size_t WS_KB = WS_QB + 194 * MiB;
constexpr size_t WS_VB = WS_KB + 194 * MiB;
constexpr size_t WS_GB = WS_VB + 194 * MiB;
constexpr size_t WS_END = WS_GB + 258 * MiB;
constexpr size_t WS_HID = WS_QB;
constexpr size_t WS_POOLED = WS_XB;
constexpr size_t WS_YPOOL = WS_XB + (size_t)M * PW * 2;
static_assert(WS_YPOOL + (size_t)M * PW * 2 <= WS_ZB, "YPOOL inside XB");
constexpr size_t WS_OATT = WS_ZB;
constexpr size_t WS_MB = WS_VB;
constexpr size_t WS_PP = WS_GB;
static_assert(WS_HID + (size_t)M * FF * 2 <= WS_VB, "HID overlay");
static_assert(WS_SS0 + (size_t)M * 4 <= WS_LSE && WS_LSE + (size_t)M * 24 * 4 <= WS_W1T, "small buffers");
static_assert(WS_W1T + (size_t)2 * FF * D * 2 <= WS_W2T && WS_W2T + (size_t)D * FF * 2 <= WS_WINT && WS_WINT + (size_t)INW * D * 2 <= WS_PMT && WS_PMT + (size_t)PW * 256 * 2 <= WS_WPOT, "weights 1");
static_assert(WS_WPOT + (size_t)D * PW * 2 <= WS_WAOT && WS_WAOT + (size_t)D * PW * 2 <= WS_WOT && WS_WOT + (size_t)D * D * 2 <= WS_W3T && WS_W3T + (size_t)2 * FF * D * 2 <= WS_W4T, "weights 2");
static_assert(WS_W4T + (size_t)D * FF * 2 <= WS_PGT && WS_PGT + (size_t)D * D * 2 <= WS_PPT && WS_PPT + (size_t)D * DPLE * 2 <= WS_PB && WS_PB + (size_t)M * DPLE * 2 <= WS_XB, "weights 3");
static_assert(WS_XB + (size_t)M * D * 2 <= WS_ZB && WS_ZB + (size_t)M * PW * 2 <= WS_QB && WS_QB + (size_t)M * QKVW * 2 <= WS_KB && WS_KB + (size_t)M * QKVW * 2 <= WS_VB, "activations 1");
static_assert(WS_VB + (size_t)M * QKVW * 2 <= WS_GB && WS_GB + (size_t)M * 4096 * 2 <= WS_END, "activations 2");
static_assert(WS_MB + (size_t)M * D * 2 <= WS_GB && WS_PP + (size_t)M * D * 2 <= WS_END && WS_OATT + (size_t)M * PW * 2 <= WS_QB && WS_POOLED + (size_t)M * PW * 2 <= WS_YPOOL, "overlays");
static_assert(WS_END <= 1390ull * MiB, "workspace budget");
constexpr int CW_TMO = 0, CW_CODE = 1, CW_BAR = 4096;
constexpr int CW_SS1 = 16384, CW_SS2 = CW_SS1 + 33280, CW_SS3 = CW_SS2 + 33280;
static_assert((CW_SS3 + 33280) * 4 <= (int)CTL_ZERO_BYTES, "CTL");

constexpr int RING_OFF = 0, RING_BYTES = 131072;
constexpr int XCH_OFF = RING_BYTES;
constexpr int MISC_OFF = XCH_OFF + 8192;
constexpr int LDS_BYTES = 147456;
static_assert(MISC_OFF + 128 <= LDS_BYTES, "LDS map");

#define GAS __attribute__((address_space(1)))
#define LAS __attribute__((address_space(3)))
typedef unsigned short bf16;
typedef unsigned v4u __attribute__((ext_vector_type(4)));
typedef unsigned v2u __attribute__((ext_vector_type(2)));
typedef float f32x4 __attribute__((ext_vector_type(4)));
typedef float f32x2 __attribute__((ext_vector_type(2)));
typedef short bf16x8 __attribute__((ext_vector_type(8)));
typedef short s16x4 __attribute__((ext_vector_type(4)));
typedef GAS unsigned gu32;
#define RLX_AGENT __ATOMIC_RELAXED, __HIP_MEMORY_SCOPE_AGENT
#define LDS_WAIT() asm volatile("s_waitcnt lgkmcnt(0)" ::: "memory")
#define VM_WAIT() asm volatile("s_waitcnt vmcnt(0)" ::: "memory")
__device__ __forceinline__ unsigned f2bf(float f) { unsigned u = __builtin_bit_cast(unsigned, f); return (u + 0x7fffu + ((u >> 16) & 1u)) >> 16; }
__device__ __forceinline__ unsigned pk2(float lo, float hi) { return f2bf(lo) | (f2bf(hi) << 16); }
__device__ __forceinline__ float bf2f(unsigned short b) { return __uint_as_float(((unsigned)b) << 16); }

#define XB_TMO      128
#define XB_XCNT(j)  (256  + 64 * (j))
#define XB_XSUB(j)  (1280 + 64 * (j))
#define XB_XGEN(j)  (2304 + 64 * (j))
#define XB_TOP      3328
#define XB_TOPGEN   3392
#define XCD_BAR_WORDS 3456
#define XB_SPIN_CAP (1u << 20)

__device__ __forceinline__ unsigned xb_ld(unsigned* p)              { return __hip_atomic_load(p, __ATOMIC_RELAXED, __HIP_MEMORY_SCOPE_AGENT); }
__device__ __forceinline__ unsigned xb_add(unsigned* p, unsigned v) { return __hip_atomic_fetch_add(p, v, __ATOMIC_RELAXED, __HIP_MEMORY_SCOPE_AGENT); }
__device__ __forceinline__ unsigned xb_xcc_id() { return (unsigned)__builtin_amdgcn_s_getreg((3 << 11) | 20) & 0xFu; }
#define XB_SPIN(cond, bar) do { unsigned _sp = 0; while (cond) { __builtin_amdgcn_s_sleep(1); \
    if ((++_sp & 255u) == 0u) { if (xb_ld(&(bar)[XB_TMO])) break; if (_sp > XB_SPIN_CAP) { atomicAdd(&(bar)[XB_TMO], 1u); break; } } } } while (0)

struct XcdBarrier { unsigned* bar; unsigned x; volatile LAS unsigned* st; };

__device__ __forceinline__ XcdBarrier xcd_barrier_post(unsigned* bar, volatile LAS unsigned* st) {
    XcdBarrier b; b.bar = bar; b.x = xb_xcc_id(); b.st = st;
    if (threadIdx.x == 0) (void)xb_add(&bar[XB_XCNT(b.x)], 1u);
    return b;
}
__device__ __forceinline__ void xcd_barrier_complete(unsigned* bar, unsigned x, unsigned& nloc, unsigned& nx) {
    const unsigned G = gridDim.x * gridDim.y * gridDim.z;
    unsigned sum, cnt, mine, sp = 0u;
    for (;;) {
        sum = 0u; cnt = 0u; mine = 0u;
#pragma unroll
        for (unsigned j = 0; j < 16; ++j) { const unsigned c = xb_ld(&bar[XB_XCNT(j)]); sum += c; cnt += (c > 0u) ? 1u : 0u; mine = (j == x) ? c : mine; }
        if (sum == G) break;
        __builtin_amdgcn_s_sleep(1);
        if ((++sp & 255u) == 0u) { if (xb_ld(&bar[XB_TMO])) break; if (sp > XB_SPIN_CAP) { atomicAdd(&bar[XB_TMO], 1u); break; } }
    }
    nloc = mine > 0u ? mine : 1u; nx = cnt > 0u ? cnt : 1u;
}
__device__ __forceinline__ void xcd_barrier(const XcdBarrier& b) {
    asm volatile("s_waitcnt vmcnt(0)" ::: "memory");
    __syncthreads();
    if (threadIdx.x == 0) {
        unsigned* bar = b.bar;
        __builtin_amdgcn_s_waitcnt(0);
        unsigned nloc = b.st[0], nx = b.st[1];
        if (nloc == 0u) { xcd_barrier_complete(bar, b.x, nloc, nx); b.st[0] = nloc; b.st[1] = nx; }
        const unsigned old = xb_add(&bar[XB_XSUB(b.x)], 1u);
        const unsigned gen = old / nloc;
        if (old + 1u == (gen + 1u) * nloc) {
            __builtin_amdgcn_fence(__ATOMIC_RELEASE, "agent");
            asm volatile("s_waitcnt vmcnt(0)" ::: "memory");
            const unsigned og = xb_add(&bar[XB_TOP], 1u);
            const unsigned tg = og / nx;
            if (og + 1u == (tg + 1u) * nx) xb_add(&bar[XB_TOPGEN], 1u);
            else XB_SPIN(xb_ld(&bar[XB_TOPGEN]) == tg, bar);
            __builtin_amdgcn_fence(__ATOMIC_ACQUIRE, "agent");
            xb_add(&bar[XB_XGEN(b.x)], 1u);
            asm volatile("s_waitcnt vmcnt(0)" ::: "memory");
        } else {
            XB_SPIN(xb_ld(&bar[XB_XGEN(b.x)]) == gen, bar);
            __builtin_amdgcn_fence(__ATOMIC_ACQUIRE, "agent");
            asm volatile("s_waitcnt vmcnt(0)" ::: "memory");
        }
    }
    __syncthreads();
}

using pg8::f32x4; using pg8::u32x4; using pg8::Unit; using pg8::pack8; using pg8::unpack8; using pg8::sigmoidf_;
typedef const f32x4 (&AccT)[2][2][4][2];

struct EpiSwiglu {
    static constexpr bool PERM = true;
    bf16* O; const float* ss;
    __device__ __forceinline__ void operator()(AccT acc, const Unit& u, int wr, int wc, int fr, int fq) const {
        bf16* Ou = O + (size_t)u.pm * 256 * FF + u.pn * 128; const float* ssu = ss + u.pm * 256;
        unsigned rl0 = wr * 64 + fr, c0 = wc * 32 + 8 * fq; asm volatile("" : "+v"(rl0), "+v"(c0));
#pragma unroll
        for (int ai = 0; ai < 2; ++ai)
#pragma unroll
            for (int m = 0; m < 4; ++m) {
                const unsigned rl = rl0 + ai * 128 + m * 16;
                const float rs = __builtin_amdgcn_rsqf(ssu[rl] * (1.0f / D) + RMS_EPS);
                f32x4 h[2];
#pragma unroll
                for (int n = 0; n < 2; ++n) { const f32x4 a = acc[ai][0][m][n] * rs, b = acc[ai][1][m][n] * rs;
#pragma unroll
                    for (int e = 0; e < 4; ++e) h[n][e] = a[e] * sigmoidf_(a[e]) * b[e]; }
                *(u32x4*)(Ou + (rl * FF + c0)) = pack8(h[0], h[1]);
            }
    }
};
struct EpiResid {
    static constexpr bool PERM = true;
    const float* base_p; const float* base_s; float* out; bf16* xb; float* ssn; float alpha;
    __device__ __forceinline__ void operator()(AccT acc, const Unit& u, int wr, int wc, int fr, int fq) const {
        const size_t uo = (size_t)u.pm * 256 * D + u.pn * 256;
        const float* bu = (u.pm < MP / 256) ? base_p + uo : base_s + u.pn * 256; float* ou = out + uo; bf16* xu = xb + uo; float* su = ssn + u.pm * 256;
        unsigned rl0 = wr * 64 + fr, c0 = wc * 32 + 8 * fq; asm volatile("" : "+v"(rl0), "+v"(c0));
#pragma unroll
        for (int ai = 0; ai < 2; ++ai)
#pragma unroll
            for (int m = 0; m < 4; ++m) {
                const unsigned rl = rl0 + ai * 128 + m * 16; const unsigned ro = rl * D + c0;
                float sq = 0.f;
#pragma unroll
                for (int bj = 0; bj < 2; ++bj) {
                    const f32x4 b0 = *(const f32x4*)(bu + (ro + bj * 128)), b1 = *(const f32x4*)(bu + (ro + bj * 128 + 4));
                    const f32x4 h0 = b0 + acc[ai][bj][m][0] * alpha, h1 = b1 + acc[ai][bj][m][1] * alpha;
                    *(f32x4*)(ou + (ro + bj * 128)) = h0; *(f32x4*)(ou + (ro + bj * 128 + 4)) = h1;
                    *(u32x4*)(xu + (ro + bj * 128)) = pack8(h0, h1);
                    sq += (h0[0] * h0[0] + h0[1] * h0[1]) + (h0[2] * h0[2] + h0[3] * h0[3]) + (h1[0] * h1[0] + h1[1] * h1[1]) + (h1[2] * h1[2] + h1[3] * h1[3]);
                }
                sq += __shfl_xor(sq, 16); sq += __shfl_xor(sq, 32);
                if (fq == 0) atomicAdd(su + rl, sq);
            }
    }
};
struct EpiWin {
    static constexpr bool PERM = true;
    unsigned char* ws; const float* ss; const float* qn; const float* kn; float* dout; LAS float* xch;
    __device__ __forceinline__ void operator()(AccT acc, const Unit& u, int wr, int wc, int fr, int fq) const {
        const int pn = u.pn, pm = u.pm; unsigned rl0 = wr * 64 + fr, cw = wc * 32 + 8 * fq; asm volatile("" : "+v"(rl0), "+v"(cw));
        const float* ssu = ss + pm * 256;
        const bool samp = pm >= MP / 256; const int pb = pm >> 3, t0 = (pm & 7) * 256;
        if (pn < 4) {
            bf16* Zu = (bf16*)(ws + WS_ZB) + (size_t)pm * 256 * PW + pn * 256;
            float* so = samp ? dout + O_SPS + 7 * PW + pn * 256 : dout + O_SPP + ((size_t)pb * 15 + t0) * PW - (size_t)(T_P - 15) * PW + pn * 256;
#pragma unroll
            for (int ai = 0; ai < 2; ++ai)
#pragma unroll
                for (int m = 0; m < 4; ++m) {
                    const unsigned rl = rl0 + ai * 128 + m * 16; const float rs = __builtin_amdgcn_rsqf(ssu[rl] * (1.0f / D) + RMS_EPS);
                    const bool keep = samp || (t0 + (int)rl >= T_P - 15);
                    const unsigned sofs = samp ? ((rl >> 3) * 15 + (rl & 7)) * PW + cw : rl * PW + cw;
#pragma unroll
                    for (int bj = 0; bj < 2; ++bj) {
                        const f32x4 v0 = acc[ai][bj][m][0] * rs, v1 = acc[ai][bj][m][1] * rs;
                        *(u32x4*)(Zu + (rl * PW + bj * 128 + cw)) = pack8(v0, v1);
                        if (keep) { *(f32x4*)(so + (sofs + bj * 128)) = v0; *(f32x4*)(so + (sofs + bj * 128 + 4)) = v1; } }
                }
        } else if (pn < 28) {
            const bool isk = pn >= 16; const int hh0 = 2 * (isk ? pn - 16 : pn - 4);
            const float* gn = isk ? kn : qn;
            const f32x4 g0 = *(const f32x4*)(gn + cw), g1 = *(const f32x4*)(gn + cw + 4);
            float rsv[2][4];
#pragma unroll
            for (int ai = 0; ai < 2; ++ai)
#pragma unroll
                for (int m = 0; m < 4; ++m) {
                    const unsigned rl = rl0 + ai * 128 + m * 16; const float rs = __builtin_amdgcn_rsqf(ssu[rl] * (1.0f / D) + RMS_EPS); rsv[ai][m] = rs;
#pragma unroll
                    for (int bj = 0; bj < 2; ++bj) { const f32x4 v0 = acc[ai][bj][m][0] * rs, v1 = acc[ai][bj][m][1] * rs;
                        float sq = (v0[0] * v0[0] + v0[1] * v0[1]) + (v0[2] * v0[2] + v0[3] * v0[3]) + (v1[0] * v1[0] + v1[1] * v1[1]) + (v1[2] * v1[2] + v1[3] * v1[3]);
                        sq += __shfl_xor(sq, 16); sq += __shfl_xor(sq, 32);
                        if (fq == 0) xch[(rl * 2 + bj) * 4 + wc] = sq; }
                }
            asm volatile("s_waitcnt lgkmcnt(0)" ::: "memory"); __builtin_amdgcn_s_barrier(); asm volatile("" ::: "memory");
            bf16* Ou = (bf16*)(ws + (isk ? WS_KB : WS_QB)) + (size_t)pm * 256 * QKVW + hh0 * HD;
            const int g = hh0 >> 3, h0 = hh0 & 7; const int keepn = (g == 0) ? 128 : (g == 1 ? 512 : 2048);
            float* co = samp ? dout + (g == 0 ? O_K0S : (g == 1 ? O_K1S : O_K2S)) + ((size_t)(keepn - 8) * 8 + h0) * HD
                             : dout + (g == 0 ? O_K0P : (g == 1 ? O_K1P : O_K2P)) + (((size_t)pb * keepn + t0) * 8 + h0) * HD - (size_t)(T_P - keepn) * 8 * HD;
#pragma unroll
            for (int ai = 0; ai < 2; ++ai)
#pragma unroll
                for (int m = 0; m < 4; ++m) {
                    const unsigned rl = rl0 + ai * 128 + m * 16; const float rs = rsv[ai][m];
                    const bool keep = isk && (samp || (t0 + (int)rl >= T_P - keepn));
                    const unsigned cofs = samp ? ((rl >> 3) * keepn + (rl & 7)) * 1024 + cw : rl * 1024 + cw;
#pragma unroll
                    for (int bj = 0; bj < 2; ++bj) {
                        const f32x4 pz = *(const LAS f32x4*)(xch + (rl * 2 + bj) * 4);
                        const float rn = rs * __builtin_amdgcn_rsqf(((pz[0] + pz[1]) + (pz[2] + pz[3])) * (1.0f / HD) + RMS_EPS);
                        const f32x4 v0 = acc[ai][bj][m][0] * rn * g0, v1 = acc[ai][bj][m][1] * rn * g1;
                        *(u32x4*)(Ou + (rl * QKVW + bj * HD + cw)) = pack8(v0, v1);
                        if (keep) { *(f32x4*)(co + (cofs + bj * HD)) = v0; *(f32x4*)(co + (cofs + bj * HD + 4)) = v1; }
                    }
                }
        } else if (pn < 40) {
            const int hh0 = 2 * (pn - 28);
            bf16* Ou = (bf16*)(ws + WS_VB) + (size_t)pm * 256 * QKVW + hh0 * HD;
            const int g = hh0 >> 3, h0 = hh0 & 7; const int keepn = (g == 0) ? 128 : (g == 1 ? 512 : 2048);
            float* co = samp ? dout + (g == 0 ? O_V0S : (g == 1 ? O_V1S : O_V2S)) + ((size_t)(keepn - 8) * 8 + h0) * HD
                             : dout + (g == 0 ? O_V0P : (g == 1 ? O_V1P : O_V2P)) + (((size_t)pb * keepn + t0) * 8 + h0) * HD - (size_t)(T_P - keepn) * 8 * HD;
#pragma unroll
            for (int ai = 0; ai < 2; ++ai)
#pragma unroll
                for (int m = 0; m < 4; ++m) {
                    const unsigned rl = rl0 + ai * 128 + m * 16; const float rs = __builtin_amdgcn_rsqf(ssu[rl] * (1.0f / D) + RMS_EPS);
                    const bool keep = samp || (t0 + (int)rl >= T_P - keepn);
                    const unsigned cofs = samp ? ((rl >> 3) * keepn + (rl & 7)) * 1024 + cw : rl * 1024 + cw;
#pragma unroll
                    for (int bj = 0; bj < 2; ++bj) {
                        const f32x4 v0 = acc[ai][bj][m][0] * rs, v1 = acc[ai][bj][m][1] * rs;
                        *(u32x4*)(Ou + (rl * QKVW + bj * HD + cw)) = pack8(v0, v1);
                        if (keep) { *(f32x4*)(co + (cofs + bj * HD)) = v0; *(f32x4*)(co + (cofs + bj * HD + 4)) = v1; }
                    }
                }
        } else {
            bf16* Gu = (bf16*)(ws + WS_GB) + (size_t)pm * 256 * 4096 + (pn - 40) * 256;
#pragma unroll
            for (int ai = 0; ai < 2; ++ai)
#pragma unroll
                for (int m = 0; m < 4; ++m) {
                    const unsigned rl = rl0 + ai * 128 + m * 16; const float rs = __builtin_amdgcn_rsqf(ssu[rl] * (1.0f / D) + RMS_EPS);
#pragma unroll
                    for (int bj = 0; bj < 2; ++bj) {
                        f32x4 v0 = acc[ai][bj][m][0] * rs, v1 = acc[ai][bj][m][1] * rs;
#pragma unroll
                        for (int e = 0; e < 4; ++e) { v0[e] = sigmoidf_(v0[e]); v1[e] = sigmoidf_(v1[e]); }
                        *(u32x4*)(Gu + (rl * 4096 + bj * 128 + cw)) = pack8(v0, v1); }
                }
        }
    }
};
struct EpiScaleCol {
    static constexpr bool PERM = true;
    bf16* O; int ldc; const float* scale;
    __device__ __forceinline__ void operator()(AccT acc, const Unit& u, int wr, int wc, int fr, int fq) const {
        bf16* Ou = O + (size_t)u.pm * 256 * ldc + u.pn * 256;
        unsigned rl0 = wr * 64 + fr, c0 = wc * 32 + 8 * fq; asm volatile("" : "+v"(rl0), "+v"(c0));
        f32x4 s[2][2];
#pragma unroll
        for (int bj = 0; bj < 2; ++bj)
#pragma unroll
            for (int n = 0; n < 2; ++n) s[bj][n] = scale ? *(const f32x4*)(scale + u.pn * 256 + (c0 + bj * 128 + 4 * n)) : (f32x4){1.f, 1.f, 1.f, 1.f};
#pragma unroll
        for (int ai = 0; ai < 2; ++ai)
#pragma unroll
            for (int m = 0; m < 4; ++m) { const unsigned rl = rl0 + ai * 128 + m * 16;
#pragma unroll
                for (int bj = 0; bj < 2; ++bj) *(u32x4*)(Ou + (rl * (unsigned)ldc + c0 + bj * 128)) = pack8(acc[ai][bj][m][0] * s[bj][0], acc[ai][bj][m][1] * s[bj][1]); }
    }
};
template <bool ADD> struct EpiGate {
    static constexpr bool PERM = true;
    bf16* MBp; const bf16* GBp; int goff;
    __device__ __forceinline__ void operator()(AccT acc, const Unit& u, int wr, int wc, int fr, int fq) const {
        bf16* Mu = MBp + (size_t)u.pm * 256 * D + u.pn * 256; const bf16* Gu = GBp + (size_t)u.pm * 256 * 4096 + goff + u.pn * 256;
        unsigned rl0 = wr * 64 + fr, c0 = wc * 32 + 8 * fq; asm volatile("" : "+v"(rl0), "+v"(c0));
#pragma unroll
        for (int ai = 0; ai < 2; ++ai)
#pragma unroll
            for (int m = 0; m < 4; ++m) { const unsigned rl = rl0 + ai * 128 + m * 16;
#pragma unroll
                for (int bj = 0; bj < 2; ++bj) {
                    f32x4 g0, g1; unpack8(*(const u32x4*)(Gu + (rl * 4096 + c0 + bj * 128)), g0, g1);
                    f32x4 r0 = g0 * acc[ai][bj][m][0], r1 = g1 * acc[ai][bj][m][1];
                    if (ADD) { f32x4 p0, p1; unpack8(*(const u32x4*)(Mu + (rl * D + c0 + bj * 128)), p0, p1); r0 += p0; r1 += p1; }
                    *(u32x4*)(Mu + (rl * D + c0 + bj * 128)) = pack8(r0, r1); } }
    }
};
struct EpiFinal {
    static constexpr bool PERM = true;
    float* out; const bf16* PPp; const float* ss;
    __device__ __forceinline__ void operator()(AccT acc, const Unit& u, int wr, int wc, int fr, int fq) const {
        const size_t uo = (size_t)u.pm * 256 * D + u.pn * 256; float* ou = out + uo; const bf16* pu = PPp + uo; const float* ssu = ss + u.pm * 256;
        unsigned rl0 = wr * 64 + fr, c0 = wc * 32 + 8 * fq; asm volatile("" : "+v"(rl0), "+v"(c0));
#pragma unroll
        for (int ai = 0; ai < 2; ++ai)
#pragma unroll
            for (int m = 0; m < 4; ++m) { const unsigned rl = rl0 + ai * 128 + m * 16; const float rs = __builtin_amdgcn_rsqf(ssu[rl] * (1.0f / D) + RMS_EPS);
#pragma unroll
                for (int bj = 0; bj < 2; ++bj) { const unsigned o = rl * D + c0 + bj * 128;
                    f32x4 p0, p1; unpack8(*(const u32x4*)(pu + o), p0, p1);
                    f32x4 h0 = *(const f32x4*)(ou + o), h1 = *(const f32x4*)(ou + (o + 4));
                    const f32x4 a0 = acc[ai][bj][m][0] * rs, a1 = acc[ai][bj][m][1] * rs;
#pragma unroll
                    for (int e = 0; e < 4; ++e) { h0[e] += sigmoidf_(a0[e]) * p0[e]; h1[e] += sigmoidf_(a1[e]) * p1[e]; }
                    *(f32x4*)(ou + o) = h0; *(f32x4*)(ou + (o + 4)) = h1; } }
    }
};

struct Frame {
    LAS unsigned char* lds; volatile LAS unsigned* MISC; gu32* ctl;
    int tid, lane, wave, G, gw, NGW;
    unsigned char* ws; float* out;
};
struct Args { const float* in[29]; float* out; unsigned char* ws; int ph_lo, ph_hi, li, pad; };
enum { I_XP = 0, I_XS, I_PP, I_PS, I_SPOOL, I_CK0, I_CV0, I_CK1, I_CV1, I_CK2, I_CV2, I_F1N, I_F1WI, I_F1WO, I_MIXN, I_WIN, I_QN, I_KN, I_PMAP, I_PSCALE, I_WPO, I_WAO, I_WO,
       I_F2N, I_F2WI, I_F2WO, I_PLEN, I_PLEG, I_PLEP };

__device__ __forceinline__ float wave_sum(float v) {
#pragma unroll
    for (int o = 1; o < 64; o <<= 1) v += __shfl_xor(v, o);
    return v;
}
__device__ __forceinline__ float wave_max(float v) {
#pragma unroll
    for (int o = 1; o < 64; o <<= 1) v = fmaxf(v, __shfl_xor(v, o));
    return v;
}
template <int MODE>
__device__ __forceinline__ void transpose_item(const float* W, int K, int N, bf16* WT, const float* gain, LAS float* scr, int item, int lane) {
    const int nblk = N / 32, kb = item / nblk, nb = item % nblk, k0 = 64 * kb, n0 = 32 * nb;
#pragma unroll 8
    for (int i = 0; i < 32; ++i) { const int kk = 2 * i + (lane >> 5); float w = W[(size_t)(k0 + kk) * N + n0 + (lane & 31)]; if (gain) w *= gain[k0 + kk]; scr[kk * 33 + (lane & 31)] = w; }
    LDS_WAIT(); asm volatile("" ::: "memory");
    const int c = lane & 7;
    int r0 = n0;
    if (MODE == 1) { const int isb = n0 >= FF ? 1 : 0, j = n0 - isb * FF; r0 = 256 * (j >> 7) + 128 * isb + (j & 127); }
#pragma unroll
    for (int j = 0; j < 4; ++j) { const int n = (lane >> 3) + 8 * j; const LAS float* s = scr + (8 * c) * 33 + n;
        v4u o; o.x = pk2(s[0 * 33], s[1 * 33]); o.y = pk2(s[2 * 33], s[3 * 33]); o.z = pk2(s[4 * 33], s[5 * 33]); o.w = pk2(s[6 * 33], s[7 * 33]);
        *(GAS v4u*)(WT + (size_t)(r0 + n) * K + k0 + 8 * c) = o; }
    LDS_WAIT(); asm volatile("" ::: "memory");
}

__device__ __forceinline__ void p0_prologue(Frame& F, const Args& a) {
    LAS float* scr = (LAS float*)(F.lds + RING_OFF + F.wave * 16384);
    unsigned char* ws = F.ws;
    {
        const int n1 = (D / 64) * (2 * FF / 32), n2 = (FF / 64) * (D / 32), n3 = (D / 64) * (INW / 32), n4 = 4 * (256 / 64) * (256 / 32), n5 = (PW / 64) * (D / 32), n6 = n5,
                  n7 = (D / 64) * (D / 32), n8 = n1, n9 = n2, n10 = n7, n11 = (DPLE / 64) * (D / 32);
        const int total = n1 + n2 + n3 + n4 + n5 + n6 + n7 + n8 + n9 + n10 + n11;
        for (int it = F.gw; it < total; it += F.NGW) {
            int r = it;
            if (r < n1) { transpose_item<1>(a.in[I_F1WI], D, 2 * FF, (bf16*)(ws + WS_W1T), a.in[I_F1N], scr, r, F.lane); continue; } r -= n1;
            if (r < n2) { transpose_item<0>(a.in[I_F1WO], FF, D, (bf16*)(ws + WS_W2T), nullptr, scr, r, F.lane); continue; } r -= n2;
            if (r < n3) { transpose_item<0>(a.in[I_WIN], D, INW, (bf16*)(ws + WS_WINT), a.in[I_MIXN], scr, r, F.lane); continue; } r -= n3;
            if (r < n4) { const int g = r / 32, rr = r % 32; transpose_item<0>(a.in[I_PMAP] + (size_t)g * 65536, 256, 256, (bf16*)(ws + WS_PMT) + (size_t)g * 65536, nullptr, scr, rr, F.lane); continue; } r -= n4;
            if (r < n5) { transpose_item<0>(a.in[I_WPO], PW, D, (bf16*)(ws + WS_WPOT), nullptr, scr, r, F.lane); continue; } r -= n5;
            if (r < n6) { transpose_item<0>(a.in[I_WAO], PW, D, (bf16*)(ws + WS_WAOT), nullptr, scr, r, F.lane); continue; } r -= n6;
            if (r < n7) { transpose_item<0>(a.in[I_WO], D, D, (bf16*)(ws + WS_WOT), nullptr, scr, r, F.lane); continue; } r -= n7;
            if (r < n8) { transpose_item<1>(a.in[I_F2WI], D, 2 * FF, (bf16*)(ws + WS_W3T), a.in[I_F2N], scr, r, F.lane); continue; } r -= n8;
            if (r < n9) { transpose_item<0>(a.in[I_F2WO], FF, D, (bf16*)(ws + WS_W4T), nullptr, scr, r, F.lane); continue; } r -= n9;
            if (r < n10) { transpose_item<0>(a.in[I_PLEG], D, D, (bf16*)(ws + WS_PGT), a.in[I_PLEN], scr, r, F.lane); continue; } r -= n10;
            transpose_item<0>(a.in[I_PLEP], DPLE, D, (bf16*)(ws + WS_PPT), nullptr, scr, r, F.lane);
        }
    }
    {
        bf16* XB = (bf16*)(ws + WS_XB); float* ss0 = (float*)(ws + WS_SS0); bf16* PB = (bf16*)(ws + WS_PB);
        for (int m = F.gw; m < M; m += F.NGW) {
            const float* xr = (m < MP) ? a.in[I_XP] + (size_t)m * D : a.in[I_XS] + (size_t)(m - MP) * D;
            const GAS f32x4* xv = (const GAS f32x4*)xr + F.lane;
            f32x4 v[8]; float s = 0.f;
#pragma unroll
            for (int j = 0; j < 8; ++j) { v[j] = xv[64 * j]; s += (v[j].x * v[j].x + v[j].y * v[j].y) + (v[j].z * v[j].z + v[j].w * v[j].w); }
            s = wave_sum(s);
            GAS v2u* o8 = (GAS v2u*)(XB + (size_t)m * D) + F.lane;
#pragma unroll
            for (int j = 0; j < 8; ++j) { v2u w; w.x = pk2(v[j].x, v[j].y); w.y = pk2(v[j].z, v[j].w); o8[64 * j] = w; }
            if (F.lane == 0) ss0[m] = s;
            const float* pr = (m < MP) ? a.in[I_PP] + (size_t)m * DPLE : a.in[I_PS] + (size_t)(m - MP) * DPLE;
            const f32x4 pv = ((const GAS f32x4*)pr)[F.lane];
            v2u w; w.x = pk2(pv.x, pv.y); w.y = pk2(pv.z, pv.w); ((GAS v2u*)(PB + (size_t)m * DPLE))[F.lane] = w;
        }
    }
    {
        const unsigned gt = blockIdx.x * 512u + (unsigned)F.tid, NT = (unsigned)F.G * 512u;
#pragma unroll 1
        for (int c = 0; c < 6; ++c) {
            const int g = c >> 1; const int L = (g == 0) ? 128 : (g == 1 ? 512 : 2048);
            const float* src = a.in[I_CK0 + c];
            float* dst = F.out + ((c == 0) ? O_K0S : (c == 1) ? O_V0S : (c == 2) ? O_K1S : (c == 3) ? O_V1S : (c == 4) ? O_K2S : O_V2S);
            const unsigned per_b = (unsigned)(L - 8) * 256u;
#pragma unroll 1
            for (int b = 0; b < NB_S; ++b) {
                const f32x4* sp = (const f32x4*)(src + (size_t)b * L * 1024 + 8192); f32x4* dp = (f32x4*)(dst + (size_t)b * L * 1024);
                for (unsigned r = gt; r < per_b; r += NT) { const f32x4 v = __builtin_nontemporal_load(sp + r); __builtin_nontemporal_store(v, dp + r); }
            }
        }
        const unsigned total = (unsigned)NB_S * 7u * 256u;
        for (unsigned i = gt; i < total; i += NT) { const unsigned b = i / (7u * 256u), r = i - b * (7u * 256u);
            ((f32x4*)(F.out + O_SPS + (size_t)b * 15 * 1024))[r] = ((const f32x4*)(a.in[I_SPOOL] + (size_t)b * 15 * 1024 + 8 * 1024))[r]; }
    }
}

__device__ __forceinline__ void pooling_phase(Frame& F, const Args& a) {
    const bf16* ZB = (const bf16*)(F.ws + WS_ZB); bf16* PO = (bf16*)(F.ws + WS_POOLED);
    const size_t gt = (size_t)blockIdx.x * 512 + F.tid, NT = (size_t)F.G * 512;
    const size_t total = (size_t)M * 128;
    for (size_t idx = gt; idx < total; idx += NT) {
        const int row = (int)(idx >> 7), c8 = (int)(idx & 127), col = c8 * 8;
        const int w = 2 << (c8 >> 5);
        float s[8];
#pragma unroll
        for (int e = 0; e < 8; ++e) s[e] = 0.f;
        f32x4 z0, z1; unpack8(*(const u32x4*)(ZB + (size_t)row * PW + col), z0, z1);
        float cnt;
        if (row < MP) {
            const int t = row & (T_P - 1); const int n = (t + 1 < w) ? t + 1 : w; cnt = (float)n;
            for (int j = 0; j < n; ++j) { f32x4 a0, a1; unpack8(*(const u32x4*)(ZB + (size_t)(row - j) * PW + col), a0, a1);
#pragma unroll
                for (int e = 0; e < 4; ++e) { s[e] += a0[e]; s[4 + e] += a1[e]; } }
        } else {
            const int r = row - MP, b = r >> 3, i = r & 7; cnt = (float)w;
            for (int j = 0; j < w; ++j) { const int e_ = 15 + i - j;
                f32x4 a0, a1;
                if (e_ >= 15) unpack8(*(const u32x4*)(ZB + (size_t)(MP + b * 8 + (e_ - 15)) * PW + col), a0, a1);
                else { const float* sp = a.in[I_SPOOL] + ((size_t)b * 15 + e_) * PW + col; a0 = *(const f32x4*)sp; a1 = *(const f32x4*)(sp + 4); }
#pragma unroll
                for (int e = 0; e < 4; ++e) { s[e] += a0[e]; s[4 + e] += a1[e]; } }
        }
        const float ic = 1.0f / cnt;
        f32x4 o0, o1;
#pragma unroll
        for (int e = 0; e < 4; ++e) { o0[e] = s[e] * ic - z0[e]; o1[e] = s[4 + e] * ic - z1[e]; }
        *(u32x4*)(PO + (size_t)row * PW + col) = pack8(o0, o1);
    }
}

__device__ __forceinline__ void merge_phase(Frame& F) {
    const bf16* OG = (const bf16*)(F.ws + WS_QB); const float* LSE = (const float*)(F.ws + WS_LSE); bf16* OA = (bf16*)(F.ws + WS_OATT);
    const size_t gt = (size_t)blockIdx.x * 512 + F.tid, NT = (size_t)F.G * 512;
    const size_t total = (size_t)M * 128;
    for (size_t idx = gt; idx < total; idx += NT) {
        const int row = (int)(idx >> 7), c8 = (int)(idx & 127), h = c8 >> 4, col = c8 * 8;
        const float l0 = LSE[(size_t)row * 24 + h], l1 = LSE[(size_t)row * 24 + 8 + h], l2 = LSE[(size_t)row * 24 + 16 + h];
        const float mx = fmaxf(l0, fmaxf(l1, l2));
        float w0 = __expf(l0 - mx), w1 = __expf(l1 - mx), w2 = __expf(l2 - mx); const float inv = 1.0f / (w0 + w1 + w2); w0 *= inv; w1 *= inv; w2 *= inv;
        f32x4 a0, a1, b0, b1, c0, c1;
        unpack8(*(const u32x4*)(OG + (size_t)row * QKVW + col), a0, a1);
        unpack8(*(const u32x4*)(OG + (size_t)row * QKVW + 1024 + col), b0, b1);
        unpack8(*(const u32x4*)(OG + (size_t)row * QKVW + 2048 + col), c0, c1);
        *(u32x4*)(OA + (size_t)row * PW + col) = pack8(a0 * w0 + b0 * w1 + c0 * w2, a1 * w0 + b1 * w1 + c1 * w2);
    }
}

__device__ __forceinline__ void sample_attn_phase(Frame& F, const Args& a) {
    bf16* QB = (bf16*)(F.ws + WS_QB); float* LSE = (float*)(F.ws + WS_LSE);
    const int lane = F.lane;
#pragma unroll 1
    for (int task = F.gw; task < NB_S * T_S * 24; task += F.NGW) {
        const int hh = task % 24, bi = task / 24, b = bi >> 3, i = bi & 7, g = hh >> 3, h = hh & 7;
        const int row = MP + bi;
        const int dil = 1 << (2 * g), L = 128 << (2 * g);
        const float* ck = a.in[I_CK0 + 2 * g]; const float* cv = a.in[I_CV0 + 2 * g];
        const size_t no = (g == 0 ? O_K0S : (g == 1 ? O_K1S : O_K2S)); const size_t vo_ = (g == 0 ? O_V0S : (g == 1 ? O_V1S : O_V2S));
        const float* nk = F.out + no; const float* nv = F.out + vo_;
        bf16* qp = QB + (size_t)row * QKVW + hh * HD + 2 * lane;
        const unsigned qw = *(const unsigned*)qp;
        const float q0 = pg8::bf_lo(qw), q1 = pg8::bf_hi(qw);
        const float slope = __builtin_amdgcn_exp2f(-(float)(h + 1));
        float sc0 = -1e30f, sc1 = -1e30f, sc2 = -1e30f;
#pragma unroll 1
        for (int j0 = 0; j0 < 136; j0 += 8) {
            f32x2 kv[8];
#pragma unroll
            for (int jj = 0; jj < 8; ++jj) { const int j = j0 + jj; const int jc = j < 129 ? j : 128; const int e_ = L + i - jc * dil;
                const float* kp = (e_ < L) ? ck + (((size_t)b * L + e_) * 8 + h) * HD : nk + (((size_t)b * L + (e_ - 8)) * 8 + h) * HD;
                kv[jj] = *(const f32x2*)(kp + 2 * lane); }
#pragma unroll
            for (int jj = 0; jj < 8; ++jj) { const int j = j0 + jj;
                float d = wave_sum(kv[jj].x * q0 + kv[jj].y * q1);
                d = d * 0.08838834764831845f - slope * (float)(j * dil);
                if (j < 129 && lane == (j & 63)) { if ((j >> 6) == 0) sc0 = d; else if ((j >> 6) == 1) sc1 = d; else sc2 = d; } }
        }
        const float mx = wave_max(fmaxf(sc0, fmaxf(sc1, sc2)));
        const float p0 = __expf(sc0 - mx), p1 = __expf(sc1 - mx), p2 = __expf(sc2 - mx);
        const float den = wave_sum(p0 + p1 + p2);
        float o0 = 0.f, o1 = 0.f;
#pragma unroll 1
        for (int j0 = 0; j0 < 136; j0 += 8) {
            f32x2 vv[8];
#pragma unroll
            for (int jj = 0; jj < 8; ++jj) { const int j = j0 + jj; const int jc = j < 129 ? j : 128; const int e_ = L + i - jc * dil;
                const float* vp = (e_ < L) ? cv + (((size_t)b * L + e_) * 8 + h) * HD : nv + (((size_t)b * L + (e_ - 8)) * 8 + h) * HD;
                vv[jj] = *(const f32x2*)(vp + 2 * lane); }
#pragma unroll
            for (int jj = 0; jj < 8; ++jj) { const int j = j0 + jj;
                const float psel = (j >> 6) == 0 ? p0 : ((j >> 6) == 1 ? p1 : p2);
                const float pj = (j < 129) ? __shfl(psel, j & 63) : 0.f;
                o0 += pj * vv[jj].x; o1 += pj * vv[jj].y; }
        }
        const float id = 1.0f / den;
        *(unsigned*)qp = pk2(o0 * id, o1 * id);
        if (lane == 0) LSE[(size_t)row * 24 + hh] = mx + __logf(den);
    }
}

__device__ __forceinline__ unsigned off_b(unsigned row, unsigned ch) { return 256u * row + 16u * (ch ^ (((row & 3) << 2) | ((row >> 2) & 3))); }
__device__ __forceinline__ void attn_phase(Frame& F) {
    const bf16* KB = (const bf16*)(F.ws + WS_KB); const bf16* VB = (const bf16*)(F.ws + WS_VB); bf16* QB = (bf16*)(F.ws + WS_QB); float* LSE = (float*)(F.ws + WS_LSE);
    LAS unsigned char* Kt = F.lds + RING_OFF; LAS unsigned char* Vt = F.lds + RING_OFF + 65536;
    const int lane = F.lane, w = F.wave, i16 = lane & 15, g4 = lane >> 4;
    const int NUNITS = NB_P * 24 * 16;
    const int per = (NUNITS + F.G - 1) / F.G;
    const int u_lo = blockIdx.x * per, u_hi = (u_lo + per < NUNITS) ? u_lo + per : NUNITS;
    for (int un = u_lo; un < u_hi; ++un) {
        const int bgh = un >> 4, sub = un & 15; const int b = bgh / 24, hh = bgh % 24, g = hh >> 3, h = hh & 7;
        const int dsh = 2 * g;
        const int dil = 1 << dsh; const int nblk = 16 >> dsh;
        const int cls = sub / nblk, blk = sub % nblk;
        const size_t rowbase = (size_t)b * T_P;
        __syncthreads();
#pragma unroll 2
        for (int c8 = 0; c8 < 8; ++c8) {
            const int c = w * 8 + c8; const int kr = 4 * c + (lane >> 4); const unsigned ph = lane & 15; const unsigned lc = ph ^ (((kr & 3) << 2) | ((kr >> 2) & 3));
            int mk = 128 * (blk - 1) + kr; mk = mk < 0 ? 0 : mk;
            const size_t tok = rowbase + (size_t)mk * dil + cls;
            const bf16* kp = KB + tok * QKVW + hh * HD + 8 * lc; const bf16* vp = VB + tok * QKVW + hh * HD + 8 * lc;
            __builtin_amdgcn_global_load_lds((const unsigned*)kp, (LAS unsigned*)(Kt + 1024 * c), 16, 0, 0);
            __builtin_amdgcn_global_load_lds((const unsigned*)vp, (LAS unsigned*)(Vt + 1024 * c), 16, 0, 0);
        }
        const int mq = 128 * blk + 16 * w + i16; const size_t qtok = rowbase + (size_t)mq * dil + cls;
        bf16x8 qf[4];
#pragma unroll
        for (int ks = 0; ks < 4; ++ks) qf[ks] = *(const bf16x8*)(QB + qtok * QKVW + hh * HD + 32 * ks + 8 * g4);
        VM_WAIT(); __syncthreads();
        const int T0 = w >> 1;
        unsigned ka0 = off_b(32u * T0 + 8u * (i16 >> 2) + (i16 & 3), g4);
        asm volatile("" : "+v"(ka0));
        f32x4 S[5][2];
#pragma unroll
        for (int T = 0; T < 5; ++T)
#pragma unroll
            for (int u = 0; u < 2; ++u) {
                S[T][u] = (f32x4){0.f, 0.f, 0.f, 0.f};
#pragma unroll
                for (int ks = 0; ks < 4; ++ks) { const bf16x8 kf = *(const LAS bf16x8*)(Kt + ((ka0 ^ (unsigned)((ks << 6) | (u << 4))) + 1024u * u + 8192u * T));
                    S[T][u] = __builtin_amdgcn_mfma_f32_16x16x32_bf16(kf, qf[ks], S[T][u], 0, 0, 0); }
            }
        const float c1 = 0.08838834764831845f * 1.4426950408889634f;
        const float c2 = __builtin_amdgcn_exp2f(-(float)(h + 1)) * (float)dil * 1.4426950408889634f;
        const int qi = 16 * w + i16;
        const int sbase = 128 + qi - 32 * T0 - 8 * g4; const unsigned smax = blk > 0 ? 128u : (unsigned)qi;
        float mx = -1e30f;
#pragma unroll
        for (int T = 0; T < 5; ++T)
#pragma unroll
            for (int u = 0; u < 2; ++u)
#pragma unroll
                for (int r = 0; r < 4; ++r) { const int steps = sbase - (32 * T + 4 * u + r);
                    const bool valid = (unsigned)steps <= smax;
                    const float l = valid ? S[T][u][r] * c1 - c2 * (float)steps : -1e30f; S[T][u][r] = l; mx = fmaxf(mx, l); }
        mx = fmaxf(mx, __shfl_xor(mx, 16)); mx = fmaxf(mx, __shfl_xor(mx, 32));
        float den = 0.f; bf16x8 pf[5];
#pragma unroll
        for (int T = 0; T < 5; ++T) { float p[8];
#pragma unroll
            for (int u = 0; u < 2; ++u)
#pragma unroll
                for (int r = 0; r < 4; ++r) { const float e = __builtin_amdgcn_exp2f(S[T][u][r] - mx); p[4 * u + r] = e; den += e; }
            v4u pw; pw.x = pg8::cvt_pk_bf16(p[0], p[1]); pw.y = pg8::cvt_pk_bf16(p[2], p[3]); pw.z = pg8::cvt_pk_bf16(p[4], p[5]); pw.w = pg8::cvt_pk_bf16(p[6], p[7]);
            pf[T] = __builtin_bit_cast(bf16x8, pw); }
        den += __shfl_xor(den, 16); den += __shfl_xor(den, 32);
        unsigned va0;
        { const unsigned q = (lane & 15) >> 2, p = lane & 3; va0 = off_b(32u * T0 + 8u * g4 + q, (p >> 1)) + 8u * (p & 1); }
        asm volatile("" : "+v"(va0));
        f32x4 O[8];
#pragma unroll
        for (int dt = 0; dt < 8; ++dt) { O[dt] = (f32x4){0.f, 0.f, 0.f, 0.f};
            const unsigned vd = va0 ^ (unsigned)(dt << 5);
#pragma unroll
            for (int T = 0; T < 5; ++T) {
                const s16x4 v0 = __builtin_amdgcn_ds_read_tr16_b64_v4i16((LAS s16x4*)(Vt + (vd + 8192u * T)));
                const s16x4 v1 = __builtin_amdgcn_ds_read_tr16_b64_v4i16((LAS s16x4*)(Vt + ((vd ^ 16u) + 1024u + 8192u * T)));
                const bf16x8 vf = (bf16x8){v0[0], v0[1], v0[2], v0[3], v1[0], v1[1], v1[2], v1[3]};
                O[dt] = __builtin_amdgcn_mfma_f32_16x16x32_bf16(vf, pf[T], O[dt], 0, 0, 0); } }
        const float id = 1.0f / den;
        bf16* op = QB + qtok * QKVW + hh * HD + 4 * g4;
#pragma unroll
        for (int dt = 0; dt < 8; ++dt) { v2u o; o.x = pg8::cvt_pk_bf16(O[dt][0] * id, O[dt][1] * id); o.y = pg8::cvt_pk_bf16(O[dt][2] * id, O[dt][3] * id); *(v2u*)(op + 16 * dt) = o; }
        if (g4 == 0) LSE[qtok * 24 + hh] = (mx + __builtin_amdgcn_logf(den)) * 0.6931471805599453f;
    }
    __syncthreads();
}

constexpr int N_PHASES = 12;
__global__ void __launch_bounds__(NWAVES * 64, 2) mk_fwd(Args args) {
    extern __shared__ __attribute__((aligned(16))) unsigned char lds[];
    Frame F;
    F.lds = (LAS unsigned char*)lds; F.MISC = (volatile LAS unsigned*)(F.lds + MISC_OFF);
    F.tid = threadIdx.x; F.lane = F.tid & 63; F.wave = __builtin_amdgcn_readfirstlane(F.tid >> 6);
    F.G = gridDim.x; F.gw = blockIdx.x * NWAVES + F.wave; F.NGW = F.G * NWAVES;
    F.ws = args.ws; F.out = args.out; F.ctl = (gu32*)(args.ws + WS_CTL);
    for (int u = F.tid; u < 32; u += NWAVES * 64) ((LAS unsigned*)(F.lds + MISC_OFF))[u] = 0u;
    __syncthreads();
    XcdBarrier bar; bar.bar = (unsigned*)(F.ctl + CW_BAR); bar.x = 0; bar.st = nullptr;
    if (MK_N_LAUNCHES == 1) bar = xcd_barrier_post((unsigned*)(F.ctl + CW_BAR), F.MISC + 8);
#define GRID_BAR() do { if (MK_N_LAUNCHES == 1) xcd_barrier(bar); } while (0)
    const int lo = args.ph_lo, hi = args.ph_hi;
#ifndef PHMASK
#define PHMASK 0xFFF
#endif
#define IN(k) (((PHMASK >> (k)) & 1) && lo <= (k) && (k) < hi)
#define BOTH(k) (IN(k) && IN((k) + 1))
    unsigned char* const ws = args.ws;
    const int cid = (int)blockIdx.x;
#define WSP(T, off) ((T*)(ws + (off)))
#define SS0 ((float*)(ws + WS_SS0))
#define SS1 ((float*)(ws + WS_CTL) + CW_SS1)
#define SS2 ((float*)(ws + WS_CTL) + CW_SS2)
#define SS3 ((float*)(ws + WS_CTL) + CW_SS3)
#define HOUT (args.out + O_Y)

    if (IN(0)) { p0_prologue(F, args); if (BOTH(0)) GRID_BAR(); }
    if (IN(1)) { pg8::Gemm g{WSP(const bf16, WS_XB), WSP(const bf16, WS_W1T), M, 2 * FF, D, D, D, 0}; pg8::StaticOrder S; S.init(M, 2 * FF, F.G, cid);
        EpiSwiglu E{WSP(bf16, WS_HID), SS0}; pg8::gemm_phase<EpiSwiglu, pg8::StaticOrder>(F.lds + RING_OFF, g, S, E); if (BOTH(1)) GRID_BAR(); }
    if (IN(2)) { pg8::Gemm g{WSP(const bf16, WS_HID), WSP(const bf16, WS_W2T), M, D, FF, FF, FF, 0}; pg8::StaticOrder S; S.init(M, D, F.G, cid);
        EpiResid E{args.in[I_XP], args.in[I_XS], HOUT, WSP(bf16, WS_XB), SS1, 0.5f}; pg8::gemm_phase<EpiResid, pg8::StaticOrder>(F.lds + RING_OFF, g, S, E); if (BOTH(2)) GRID_BAR(); }
    if (IN(3)) { pg8::Gemm g{WSP(const bf16, WS_XB), WSP(const bf16, WS_WINT), M, INW, D, D, D, 0}; pg8::StaticOrder S; S.init(M, INW, F.G, cid);
        EpiWin E{ws, SS1, args.in[I_QN], args.in[I_KN], args.out, (LAS float*)(F.lds + XCH_OFF)};
        pg8::gemm_phase<EpiWin, pg8::StaticOrder>(F.lds + RING_OFF, g, S, E); if (BOTH(3)) GRID_BAR(); }
    if (IN(4)) { pooling_phase(F, args); sample_attn_phase(F, args); attn_phase(F); if (BOTH(4)) GRID_BAR(); }
    if (IN(5)) { pg8::Gemm g{WSP(const bf16, WS_POOLED), WSP(const bf16, WS_PMT), M, PW, 256, PW, 256, 256}; pg8::StaticOrder S; S.init(M, PW, F.G, cid);
        EpiScaleCol E{WSP(bf16, WS_YPOOL), PW, args.in[I_PSCALE]}; pg8::gemm_phase<EpiScaleCol, pg8::StaticOrder>(F.lds + RING_OFF, g, S, E);
        merge_phase(F); if (BOTH(5)) GRID_BAR(); }
    if (IN(6)) { pg8::Gemm g{WSP(const bf16, WS_YPOOL), WSP(const bf16, WS_WPOT), M, D, PW, PW, PW, 0}; pg8::StaticOrder S; S.init(M, D, F.G, cid);
        EpiGate<false> E{WSP(bf16, WS_MB), WSP(const bf16, WS_GB), 0}; pg8::gemm_phase<EpiGate<false>, pg8::StaticOrder>(F.lds + RING_OFF, g, S, E); if (BOTH(6)) GRID_BAR(); }
    if (IN(7)) { pg8::Gemm g{WSP(const bf16, WS_OATT), WSP(const bf16, WS_WAOT), M, D, PW, PW, PW, 0}; pg8::StaticOrder S; S.init(M, D, F.G, cid);
        EpiGate<true> E{WSP(bf16, WS_MB), WSP(const bf16, WS_GB), 2048}; pg8::gemm_phase<EpiGate<true>, pg8::StaticOrder>(F.lds + RING_OFF, g, S, E); if (BOTH(7)) GRID_BAR(); }
    if (IN(8)) { { pg8::Gemm g{WSP(const bf16, WS_MB), WSP(const bf16, WS_WOT), M, D, D, D, D, 0}; pg8::StaticOrder S; S.init(M, D, F.G, cid);
          EpiResid E{HOUT, HOUT + (size_t)MP * D, HOUT, WSP(bf16, WS_XB), SS2, 1.0f}; pg8::gemm_phase<EpiResid, pg8::StaticOrder>(F.lds + RING_OFF, g, S, E); }
        { pg8::Gemm g{WSP(const bf16, WS_PB), WSP(const bf16, WS_PPT), M, D, DPLE, DPLE, DPLE, 0}; pg8::StaticOrder S; S.init(M, D, F.G, cid);
          EpiScaleCol E{WSP(bf16, WS_PP), D, nullptr}; pg8::gemm_phase<EpiScaleCol, pg8::StaticOrder>(F.lds + RING_OFF, g, S, E); }
        if (BOTH(8)) GRID_BAR(); }
    if (IN(9)) { pg8::Gemm g{WSP(const bf16, WS_XB), WSP(const bf16, WS_W3T), M, 2 * FF, D, D, D, 0}; pg8::StaticOrder S; S.init(M, 2 * FF, F.G, cid);
        EpiSwiglu E{WSP(bf16, WS_HID), SS2}; pg8::gemm_phase<EpiSwiglu, pg8::StaticOrder>(F.lds + RING_OFF, g, S, E); if (BOTH(9)) GRID_BAR(); }
    if (IN(10)) { pg8::Gemm g{WSP(const bf16, WS_HID), WSP(const bf16, WS_W4T), M, D, FF, FF, FF, 0}; pg8::StaticOrder S; S.init(M, D, F.G, cid);
        EpiResid E{HOUT, HOUT + (size_t)MP * D, HOUT, WSP(bf16, WS_XB), SS3, 0.5f}; pg8::gemm_phase<EpiResid, pg8::StaticOrder>(F.lds + RING_OFF, g, S, E); if (BOTH(10)) GRID_BAR(); }
    if (IN(11)) { pg8::Gemm g{WSP(const bf16, WS_XB), WSP(const bf16, WS_PGT), M, D, D, D, D, 0}; pg8::StaticOrder S; S.init(M, D, F.G, cid);
        EpiFinal E{HOUT, WSP(const bf16, WS_PP), SS3}; pg8::gemm_phase<EpiFinal, pg8::StaticOrder>(F.lds + RING_OFF, g, S, E); }
#undef IN
#undef BOTH
}

extern "C" void kernel_launch(void* const* d_in, const int* in_sizes, int n_in, void* d_out, int out_size, void* d_ws, size_t ws_size, hipStream_t stream) {
    static int grid = 0;
    if (grid == 0) {
        if (n_in != 29 || (size_t)out_size != O_END || ws_size < WS_END) { fprintf(stderr, "kernel_launch: unexpected sizes: n_in %d out %d ws %zu (need %zu)\n", n_in, out_size, ws_size, (size_t)WS_END); grid = -1; return; }
        int dev = 0, cus = 0;
        if (hipGetDevice(&dev) != hipSuccess || hipDeviceGetAttribute(&cus, hipDeviceAttributeMultiprocessorCount, dev) != hipSuccess) { grid = -1; return; }
        if (hipFuncSetAttribute((const void*)mk_fwd, hipFuncAttributeMaxDynamicSharedMemorySize, LDS_BYTES) != hipSuccess) { grid = -1; return; }
        int per_cu = 0;
        (void)hipOccupancyMaxActiveBlocksPerMultiprocessor(&per_cu, (const void*)mk_fwd, NWAVES * 64, LDS_BYTES);
        (void)hipGetLastError();
        grid = cus;
    }
    if (grid < 0) return;
    (void)hipMemsetAsync((char*)d_ws + WS_CTL, 0, CTL_ZERO_BYTES, stream);
    Args a{};
    for (int i = 0; i < 29; ++i) a.in[i] = (const float*)d_in[i];
    a.out = (float*)d_out; a.ws = (unsigned char*)d_ws;
    if (MK_N_LAUNCHES == 1) { a.ph_lo = 0; a.ph_hi = N_PHASES; a.li = 0; hipLaunchKernelGGL(mk_fwd, dim3(grid), dim3(NWAVES * 64), LDS_BYTES, stream, a); }
    else for (int li = 0; li < N_PHASES; ++li) { a.ph_lo = li; a.ph_hi = li + 1; a.li = li; hipLaunchKernelGGL(mk_fwd, dim3(grid), dim3(NWAVES * 64), LDS_BYTES, stream, a); }
}
```

```cpp
#include <hip/hip_runtime.h>
#include <cstdio>
#include <cstdint>

#ifndef MK_N_LAUNCHES
#define MK_N_LAUNCHES 1
#endif

namespace pg8 {
#define PG8_LAS __attribute__((address_space(3)))
typedef unsigned short bf16_t;
typedef short bf16x8 __attribute__((ext_vector_type(8)));
typedef float f32x4 __attribute__((ext_vector_type(4)));
typedef unsigned u32x4 __attribute__((ext_vector_type(4)));
typedef unsigned u32x2 __attribute__((ext_vector_type(2)));
constexpr int BM = 256, BK = 64, HALF = 128, HTB = HALF * BK * 2, STAGE_BYTES = 8 * HTB, NXCD = 8, WGM = 8;

__host__ __device__ __forceinline__ int lds_byte(int r, int c) { const int st = (r >> 4) * 2 + (c >> 5), rr = r & 15, cc = c & 31, ob = rr * 64 + cc * 2; return st * 1024 + (ob ^ (((ob >> 9) & 1) << 5)); }
__host__ __device__ __forceinline__ void stage_rc(int b, int& R, int& C) { const int st = b / 1024, sb = b % 1024, swz = sb ^ (((sb >> 9) & 1) << 5); R = (st >> 1) * 16 + swz / 64; C = (st & 1) * 32 + (swz % 64) / 2; }
__host__ __device__ __forceinline__ int perm32(int rho) { const int n = rho >> 4, i = rho & 15; return 8 * (i >> 2) + 4 * n + (i & 3); }

struct Unit { int pm, pn; };
struct Gemm { const bf16_t* A; const bf16_t* Bt; int M, N, K, lda, ldb, a_pn_off; };

struct StaticOrder {
    int nM, nN, nwg, G, c;
    __host__ __device__ void init(int M, int N, int G_, int c_) { nM = M / BM; nN = N / BM; nwg = nM * nN; G = G_; c = c_; }
    __host__ __device__ bool next(int i, Unit& u) const {
        const long L = (long)i * G + c; if (L >= nwg) return false;
        int wgid = (int)L; { const int q = nwg / NXCD, r = nwg % NXCD, xcd = wgid % NXCD, off = wgid / NXCD; wgid = (xcd < r ? xcd * (q + 1) : r * (q + 1) + (xcd - r) * q) + off; }
        const int nig = WGM * nN, gid = wgid / nig, fm = gid * WGM, gsz = (nM - fm) < WGM ? (nM - fm) : WGM;
        u.pm = fm + ((wgid % nig) % gsz); u.pn = (wgid % nig) / gsz; return true;
    }
    __device__ __forceinline__ void a_ready(const Unit&) const {}
    __device__ __forceinline__ void done(const Unit&) const {}
};

__device__ __forceinline__ unsigned cvt_pk_bf16(float lo, float hi) { unsigned r; asm volatile("v_cvt_pk_bf16_f32 %0, %1, %2" : "=v"(r) : "v"(lo), "v"(hi)); return r; }
__device__ __forceinline__ float bf_lo(unsigned w) { return __uint_as_float(w << 16); }
__device__ __forceinline__ float bf_hi(unsigned w) { return __uint_as_float(w & 0xffff0000u); }
__device__ __forceinline__ u32x4 pack8(const f32x4& v0, const f32x4& v1) { u32x4 w; w.x = cvt_pk_bf16(v0[0], v0[1]); w.y = cvt_pk_bf16(v0[2], v0[3]); w.z = cvt_pk_bf16(v1[0], v1[1]); w.w = cvt_pk_bf16(v1[2], v1[3]); return w; }
__device__ __forceinline__ void unpack8(const u32x4& w, f32x4& v0, f32x4& v1) { v0 = (f32x4){bf_lo(w.x), bf_hi(w.x), bf_lo(w.y), bf_hi(w.y)}; v1 = (f32x4){bf_lo(w.z), bf_hi(w.z), bf_lo(w.w), bf_hi(w.w)}; }
__device__ __forceinline__ float sigmoidf_(float x) { return __builtin_amdgcn_rcpf(1.0f + __builtin_amdgcn_exp2f(-1.4426950408889634f * x)); }

template <class Epi, class Sched, bool ALIGN_EPI = true, bool SP2 = true>
__device__ __forceinline__ void gemm_phase(PG8_LAS unsigned char* lds, const Gemm g, const Sched& S, const Epi& E) {
    int tid_ = threadIdx.x; asm volatile("" : "+v"(tid_));
    const int tid = tid_, wid = __builtin_amdgcn_readfirstlane(tid >> 6), lane = tid & 63, wr = wid >> 2, wc = wid & 3, fr = lane & 15, fq = lane >> 4;
    int K_ = g.K; asm volatile("" : "+s"(K_));
    const int K = K_, nt = K / BK;
    unsigned voffA[2], voffB[2];
#pragma unroll
    for (int i = 0; i < 2; ++i) { int R, C; stage_rc(tid * 16 + i * 8192, R, C); const int Rb = Epi::PERM ? ((R & ~31) + perm32(R & 31)) : R;
        voffA[i] = (unsigned)(R * g.lda + C) * 2u; voffB[i] = (unsigned)(Rb * g.ldb + C) * 2u; }
    const unsigned kstep = (unsigned)(BK * 2);
    const unsigned hstepA = (unsigned)HALF * g.lda * 2, hstepB = (unsigned)HALF * g.ldb * 2;
    const unsigned tstepA = 2 * hstepA, tstepB = 2 * hstepB;
    const unsigned ldsw = (unsigned)wid * 1024u;
    const int aoff = lds_byte(wr * 64 + fr, fq * 8), boff = lds_byte(wc * 32 + fr, fq * 8);
#define PG8_SA(b, h) (((b) * 2 + (h)) * HTB)
#define PG8_SB(b, h) ((4 + (b) * 2 + (h)) * HTB)
#define PG8_STAGE(bufoff, gbase, voff) do { _Pragma("unroll") for (int _i = 0; _i < 2; ++_i) \
        __builtin_amdgcn_global_load_lds((const unsigned*)((const char*)(gbase) + (voff)[_i]), (PG8_LAS unsigned*)(lds + (bufoff) + ldsw + _i * 8192), 16, 0, 0); } while (0)
#define PG8_LDA(dst, b, h) do { _Pragma("unroll") for (int m = 0; m < 4; ++m) _Pragma("unroll") for (int k = 0; k < 2; ++k) dst[m][k] = *(const PG8_LAS bf16x8*)(lds + PG8_SA(b, h) + aoff + m * 2048 + k * 1024); } while (0)
#define PG8_LDB(dst, b, h) do { _Pragma("unroll") for (int n = 0; n < 2; ++n) _Pragma("unroll") for (int k = 0; k < 2; ++k) dst[n][k] = *(const PG8_LAS bf16x8*)(lds + PG8_SB(b, h) + boff + n * 2048 + k * 1024); } while (0)
#define PG8_MMA(ai, bj, At, Bt) do { __builtin_amdgcn_s_setprio(1); _Pragma("unroll") for (int m = 0; m < 4; ++m) _Pragma("unroll") for (int n = 0; n < 2; ++n) _Pragma("unroll") for (int k = 0; k < 2; ++k) \
        acc[ai][bj][m][n] = __builtin_amdgcn_mfma_f32_16x16x32_bf16(Bt[n][k], At[m][k], acc[ai][bj][m][n], 0, 0, 0); __builtin_amdgcn_s_setprio(0); } while (0)
#define PG8_WAIT_V(n) asm volatile("s_waitcnt vmcnt(" #n ")" ::: "memory")
#define PG8_WAIT_L(n) asm volatile("s_waitcnt lgkmcnt(" #n ")" ::: "memory")
#define PG8_BAR __builtin_amdgcn_s_barrier()
#define PG8_SCHED __builtin_amdgcn_sched_barrier(0)
    Unit cur, nxt; int ui = 0;
    if (!S.next(0, cur)) return;
    f32x4 acc[2][2][4][2];
#pragma unroll
    for (int a = 0; a < 2; ++a)
#pragma unroll
        for (int b = 0; b < 2; ++b)
#pragma unroll
            for (int m = 0; m < 4; ++m)
#pragma unroll
                for (int n = 0; n < 2; ++n) acc[a][b][m][n] = (f32x4){0.f, 0.f, 0.f, 0.f};
    bf16x8 At[4][2], B0[2][2], B1[2][2];
    const char* cA = (const char*)g.A + (size_t)cur.pm * tstepA + (size_t)cur.pn * g.a_pn_off * 2; const char* cB = (const char*)g.Bt + (size_t)cur.pn * tstepB;
    S.a_ready(cur);
    if constexpr (SP2) {
        PG8_STAGE(PG8_SB(0, 0), cB, voffB); PG8_STAGE(PG8_SB(0, 1), cB + hstepB, voffB); PG8_STAGE(PG8_SA(0, 0), cA, voffA); PG8_STAGE(PG8_SA(0, 1), cA + hstepA, voffA);
        if (wr == 1) PG8_BAR;
        PG8_WAIT_V(2); PG8_BAR;
        PG8_STAGE(PG8_SB(1, 0), cB + kstep, voffB); PG8_STAGE(PG8_SA(1, 0), cA + kstep, voffA); PG8_STAGE(PG8_SB(1, 1), cB + hstepB + kstep, voffB);
        PG8_WAIT_V(6); PG8_BAR;
    } else {
        PG8_STAGE(PG8_SB(0, 0), cB, voffB); PG8_STAGE(PG8_SA(0, 0), cA, voffA); PG8_STAGE(PG8_SB(0, 1), cB + hstepB, voffB); PG8_STAGE(PG8_SA(0, 1), cA + hstepA, voffA);
        if (wr == 1) PG8_BAR;
        PG8_WAIT_V(4); PG8_BAR;
        PG8_STAGE(PG8_SB(1, 0), cB + kstep, voffB); PG8_STAGE(PG8_SA(1, 0), cA + kstep, voffA); PG8_STAGE(PG8_SB(1, 1), cB + hstepB + kstep, voffB);
        PG8_WAIT_V(6); PG8_BAR;
    }
    for (;;) {
        const bool has_next = S.next(ui + 1, nxt);
        const char* nA = has_next ? (const char*)g.A + (size_t)nxt.pm * tstepA + (size_t)nxt.pn * g.a_pn_off * 2 : cA; const char* nB = has_next ? (const char*)g.Bt + (size_t)nxt.pn * tstepB : cB;
        for (int t = 0; t < nt; t += 2) {
            const bool last = (t == nt - 2);
            const char* a1 = cA + (size_t)(t + 1) * kstep;
            const char* a2 = last ? nA : cA + (size_t)(t + 2) * kstep; const char* b2 = last ? nB : cB + (size_t)(t + 2) * kstep;
            const char* a3 = a2 + kstep; const char* b3 = b2 + kstep;
            if (last && has_next) S.a_ready(nxt);
            if constexpr (SP2) {
            PG8_LDB(B0, 0, 0); PG8_LDB(B1, 0, 1); PG8_SCHED; PG8_LDA(At, 0, 0); PG8_STAGE(PG8_SA(1, 1), a1 + hstepA, voffA);
            PG8_WAIT_V(8); PG8_WAIT_L(0); PG8_BAR; PG8_MMA(0, 0, At, B0); PG8_MMA(0, 1, At, B1); PG8_BAR; PG8_SCHED;
            PG8_LDA(At, 0, 1); PG8_STAGE(PG8_SB(0, 0), b2, voffB); PG8_STAGE(PG8_SB(0, 1), b2 + hstepB, voffB); PG8_STAGE(PG8_SA(0, 0), a2, voffA);
            PG8_WAIT_V(8); PG8_WAIT_L(0); PG8_BAR; PG8_MMA(1, 0, At, B0); PG8_MMA(1, 1, At, B1); PG8_BAR; PG8_SCHED;
            PG8_LDB(B0, 1, 0); PG8_LDB(B1, 1, 1); PG8_SCHED; PG8_LDA(At, 1, 0); PG8_STAGE(PG8_SA(0, 1), a2 + hstepA, voffA);
            PG8_WAIT_V(8); PG8_WAIT_L(0); PG8_BAR; PG8_MMA(0, 0, At, B0); PG8_MMA(0, 1, At, B1); PG8_BAR; PG8_SCHED;
            PG8_LDA(At, 1, 1); PG8_STAGE(PG8_SB(1, 0), b3, voffB); PG8_STAGE(PG8_SB(1, 1), b3 + hstepB, voffB); PG8_STAGE(PG8_SA(1, 0), a3, voffA);
            PG8_WAIT_V(8); PG8_WAIT_L(0); PG8_BAR; PG8_MMA(1, 0, At, B0); PG8_MMA(1, 1, At, B1); PG8_BAR; PG8_SCHED;
            } else {
            PG8_LDB(B0, 0, 0); PG8_SCHED; PG8_LDA(At, 0, 0); PG8_STAGE(PG8_SA(1, 1), a1 + hstepA, voffA);
            PG8_WAIT_L(8); PG8_BAR; PG8_WAIT_L(0); PG8_MMA(0, 0, At, B0); PG8_BAR; PG8_SCHED;
            PG8_LDB(B1, 0, 1); PG8_STAGE(PG8_SB(0, 0), b2, voffB);
            PG8_BAR; PG8_WAIT_L(0); PG8_MMA(0, 1, At, B1); PG8_BAR;
            PG8_LDA(At, 0, 1); PG8_STAGE(PG8_SA(0, 0), a2, voffA);
            PG8_BAR; PG8_WAIT_L(0); PG8_MMA(1, 0, At, B0); PG8_BAR; PG8_SCHED;
            PG8_STAGE(PG8_SB(0, 1), b2 + hstepB, voffB);
            PG8_WAIT_V(6); PG8_BAR; PG8_MMA(1, 1, At, B1); PG8_BAR;
            PG8_LDB(B0, 1, 0); PG8_SCHED; PG8_LDA(At, 1, 0); PG8_STAGE(PG8_SA(0, 1), a2 + hstepA, voffA);
            PG8_WAIT_L(8); PG8_BAR; PG8_WAIT_L(0); PG8_MMA(0, 0, At, B0); PG8_BAR; PG8_SCHED;
            PG8_LDB(B1, 1, 1); PG8_STAGE(PG8_SB(1, 0), b3, voffB);
            PG8_BAR; PG8_WAIT_L(0); PG8_MMA(0, 1, At, B1); PG8_BAR;
            PG8_LDA(At, 1, 1); PG8_STAGE(PG8_SA(1, 0), a3, voffA);
            PG8_BAR; PG8_WAIT_L(0); PG8_MMA(1, 0, At, B0); PG8_BAR; PG8_SCHED;
            PG8_STAGE(PG8_SB(1, 1), b3 + hstepB, voffB);
            PG8_WAIT_V(6); PG8_BAR; PG8_MMA(1, 1, At, B1); PG8_BAR;
            }
        }
        if constexpr (ALIGN_EPI) { if (wr == 0) PG8_BAR; }
        E(acc, cur, wr, wc, fr, fq);
        if (!has_next) break;
#pragma unroll
        for (int a = 0; a < 2; ++a)
#pragma unroll
            for (int b = 0; b < 2; ++b)
#pragma unroll
                for (int m = 0; m < 4; ++m)
#pragma unroll
                    for (int n = 0; n < 2; ++n) acc[a][b][m][n] = (f32x4){0.f, 0.f, 0.f, 0.f};
        cur = nxt; cA = nA; cB = nB; ++ui;
        if constexpr (ALIGN_EPI) { if (wr == 1) PG8_BAR; }
    }
    PG8_WAIT_V(0);
    if constexpr (!ALIGN_EPI) { if (wr == 0) PG8_BAR; }
    PG8_BAR;
#undef PG8_SA
#undef PG8_SB
#undef PG8_STAGE
#undef PG8_LDA
#undef PG8_LDB
#undef PG8_MMA
#undef PG8_WAIT_V
#undef PG8_WAIT_L
#undef PG8_BAR
#undef PG8_SCHED
}
}

constexpr int NWAVES = 8;
constexpr int D = 2048, FF = 5632, PW = 1024, QKVW = 3072, INW = 14336, DPLE = 256, HD = 128;
constexpr int NB_P = 16, T_P = 2048, NB_S = 32, T_S = 8;
constexpr int MP = NB_P * T_P, MS = NB_S * T_S, M = MP + MS;
constexpr float RMS_EPS = 1e-6f;
static_assert(M % 256 == 0, "M");

constexpr size_t O_Y = 0;
constexpr size_t O_SPP = (size_t)M * D;
constexpr size_t O_K0P = O_SPP + (size_t)16 * 15 * 1024;
constexpr size_t O_V0P = O_K0P + (size_t)16 * 128 * 1024;
constexpr size_t O_K1P = O_V0P + (size_t)16 * 128 * 1024;
constexpr size_t O_V1P = O_K1P + (size_t)16 * 512 * 1024;
constexpr size_t O_K2P = O_V1P + (size_t)16 * 512 * 1024;
constexpr size_t O_V2P = O_K2P + (size_t)16 * 2048 * 1024;
constexpr size_t O_SPS = O_V2P + (size_t)16 * 2048 * 1024;
constexpr size_t O_K0S = O_SPS + (size_t)32 * 15 * 1024;
constexpr size_t O_V0S = O_K0S + (size_t)32 * 128 * 1024;
constexpr size_t O_K1S = O_V0S + (size_t)32 * 128 * 1024;
constexpr size_t O_V1S = O_K1S + (size_t)32 * 512 * 1024;
constexpr size_t O_K2S = O_V1S + (size_t)32 * 512 * 1024;
constexpr size_t O_V2S = O_K2S + (size_t)32 * 2048 * 1024;
constexpr size_t O_END = O_V2S + (size_t)32 * 2048 * 1024;
static_assert(O_END == 332611584ull, "d_out size");

constexpr size_t MiB = 1u << 20;
constexpr size_t WS_CTL = 0, CTL_ZERO_BYTES = 1 * MiB;
constexpr size_t WS_SS0 = 1 * MiB;
constexpr size_t WS_LSE = 2 * MiB;
constexpr size_t WS_W1T = 8 * MiB;
constexpr size_t WS_W2T = WS_W1T + 44 * MiB;
constexpr size_t WS_WINT = WS_W2T + 22 * MiB;
constexpr size_t WS_PMT = WS_WINT + 56 * MiB;
constexpr size_t WS_WPOT = WS_PMT + 1 * MiB;
constexpr size_t WS_WAOT = WS_WPOT + 4 * MiB;
constexpr size_t WS_WOT = WS_WAOT + 4 * MiB;
constexpr size_t WS_W3T = WS_WOT + 8 * MiB;
constexpr size_t WS_W4T = WS_W3T + 44 * MiB;
constexpr size_t WS_PGT = WS_W4T + 22 * MiB;
constexpr size_t WS_PPT = WS_PGT + 8 * MiB;
constexpr size_t WS_PB = WS_PPT + 1 * MiB;
constexpr size_t WS_XB = WS_PB + 17 * MiB;
constexpr size_t WS_ZB = WS_XB + 129 * MiB;
constexpr size_t WS_QB = WS_ZB + 65 * MiB;
constexpr size_t WS_KB = WS_QB + 194 * MiB;
constexpr size_t WS_VB = WS_KB + 194 * MiB;
constexpr size_t WS_GB = WS_VB + 194 * MiB;
constexpr size_t WS_END = WS_GB + 258 * MiB;
constexpr size_t WS_HID = WS_QB;
constexpr size_t WS_POOLED = WS_XB;
constexpr size_t WS_YPOOL = WS_XB + (size_t)M * PW * 2;
static_assert(WS_YPOOL + (size_t)M * PW * 2 <= WS_ZB, "YPOOL inside XB");
constexpr size_t WS_OATT = WS_ZB;
constexpr size_t WS_MB = WS_VB;
constexpr size_t WS_PP = WS_GB;
static_assert(WS_HID + (size_t)M * FF * 2 <= WS_VB, "HID overlay");
static_assert(WS_SS0 + (size_t)M * 4 <= WS_LSE && WS_LSE + (size_t)M * 24 * 4 <= WS_W1T, "small buffers");
static_assert(WS_W1T + (size_t)2 * FF * D * 2 <= WS_W2T && WS_W2T + (size_t)D * FF * 2 <= WS_WINT && WS_WINT + (size_t)INW * D * 2 <= WS_PMT && WS_PMT + (size_t)PW * 256 * 2 <= WS_WPOT, "weights 1");
static_assert(WS_WPOT + (size_t)D * PW * 2 <= WS_WAOT && WS_WAOT + (size_t)D * PW * 2 <= WS_WOT && WS_WOT + (size_t)D * D * 2 <= WS_W3T && WS_W3T + (size_t)2 * FF * D * 2 <= WS_W4T, "weights 2");
static_assert(WS_W4T + (size_t)D * FF * 2 <= WS_PGT && WS_PGT + (size_t)D * D * 2 <= WS_PPT && WS_PPT + (size_t)D * DPLE * 2 <= WS_PB && WS_PB + (size_t)M * DPLE * 2 <= WS_XB, "weights 3");
static_assert(WS_XB + (size_t)M * D * 2 <= WS_ZB && WS_ZB + (size_t)M * PW * 2 <= WS_QB && WS_QB + (size_t)M * QKVW * 2 <= WS_KB && WS_KB + (size_t)M * QKVW * 2 <= WS_VB, "activations 1");
static_assert(WS_VB + (size_t)M * QKVW * 2 <= WS_GB && WS_GB + (size_t)M * 4096 * 2 <= WS_END, "activations 2");
static_assert(WS_MB + (size_t)M * D * 2 <= WS_GB && WS_PP + (size_t)M * D * 2 <= WS_END && WS_OATT + (size_t)M * PW * 2 <= WS_QB && WS_POOLED + (size_t)M * PW * 2 <= WS_YPOOL, "overlays");
static_assert(WS_END <= 1390ull * MiB, "workspace budget");
constexpr int CW_TMO = 0, CW_CODE = 1, CW_BAR = 4096;
constexpr int CW_SS1 = 16384, CW_SS2 = CW_SS1 + 33280, CW_SS3 = CW_SS2 + 33280;
static_assert((CW_SS3 + 33280) * 4 <= (int)CTL_ZERO_BYTES, "CTL");

constexpr int RING_OFF = 0, RING_BYTES = 131072;
constexpr int XCH_OFF = RING_BYTES;
constexpr int MISC_OFF = XCH_OFF + 8192;
constexpr int LDS_BYTES = 147456;
static_assert(MISC_OFF + 128 + 128 <= LDS_BYTES, "LDS map");

#define GAS __attribute__((address_space(1)))
#define LAS __attribute__((address_space(3)))
typedef unsigned short bf16;
typedef unsigned v4u __attribute__((ext_vector_type(4)));
typedef unsigned v2u __attribute__((ext_vector_type(2)));
typedef float f32x4 __attribute__((ext_vector_type(4)));
typedef float f32x2 __attribute__((ext_vector_type(2)));
typedef short bf16x8 __attribute__((ext_vector_type(8)));
typedef short s16x4 __attribute__((ext_vector_type(4)));
typedef GAS unsigned gu32;
#define RLX_AGENT __ATOMIC_RELAXED, __HIP_MEMORY_SCOPE_AGENT
#define LDS_WAIT() asm volatile("s_waitcnt lgkmcnt(0)" ::: "memory")
#define VM_WAIT() asm volatile("s_waitcnt vmcnt(0)" ::: "memory")
__device__ __forceinline__ unsigned f2bf(float f) { unsigned u = __builtin_bit_cast(unsigned, f); return (u + 0x7fffu + ((u >> 16) & 1u)) >> 16; }
__device__ __forceinline__ unsigned pk2(float lo, float hi) { return f2bf(lo) | (f2bf(hi) << 16); }
__device__ __forceinline__ float bf2f(unsigned short b) { return __uint_as_float(((unsigned)b) << 16); }

#define XB_TMO      128
#define XB_XCNT(j)  (256  + 64 * (j))
#define XB_XSUB(j)  (1280 + 64 * (j))
#define XB_XGEN(j)  (2304 + 64 * (j))
#define XB_TOP      3328
#define XB_TOPGEN   3392
#define XCD_BAR_WORDS 3456
#define XB_SPIN_CAP (1u << 20)

__device__ __forceinline__ unsigned xb_ld(unsigned* p)              { return __hip_atomic_load(p, __ATOMIC_RELAXED, __HIP_MEMORY_SCOPE_AGENT); }
__device__ __forceinline__ unsigned xb_add(unsigned* p, unsigned v) { return __hip_atomic_fetch_add(p, v, __ATOMIC_RELAXED, __HIP_MEMORY_SCOPE_AGENT); }
__device__ __forceinline__ unsigned xb_xcc_id() { return (unsigned)__builtin_amdgcn_s_getreg((3 << 11) | 20) & 0xFu; }
#define XB_SPIN(cond, bar) do { unsigned _sp = 0; while (cond) { __builtin_amdgcn_s_sleep(1); \
    if ((++_sp & 255u) == 0u) { if (xb_ld(&(bar)[XB_TMO])) break; if (_sp > XB_SPIN_CAP) { atomicAdd(&(bar)[XB_TMO], 1u); break; } } } } while (0)

struct XcdBarrier { unsigned* bar; unsigned x; volatile LAS unsigned* st; };

__device__ __forceinline__ XcdBarrier xcd_barrier_post(unsigned* bar, volatile LAS unsigned* st) {
    XcdBarrier b; b.bar = bar; b.x = xb_xcc_id(); b.st = st;
    if (threadIdx.x == 0) (void)xb_add(&bar[XB_XCNT(b.x)], 1u);
    return b;
}
__device__ __forceinline__ void xcd_barrier_complete(unsigned* bar, unsigned x, unsigned& nloc, unsigned& nx) {
    const unsigned G = gridDim.x * gridDim.y * gridDim.z;
    unsigned sum, cnt, mine, sp = 0u;
    for (;;) {
        sum = 0u; cnt = 0u; mine = 0u;
#pragma unroll
        for (unsigned j = 0; j < 16; ++j) { const unsigned c = xb_ld(&bar[XB_XCNT(j)]); sum += c; cnt += (c > 0u) ? 1u : 0u; mine = (j == x) ? c : mine; }
        if (sum == G) break;
        __builtin_amdgcn_s_sleep(1);
        if ((++sp & 255u) == 0u) { if (xb_ld(&bar[XB_TMO])) break; if (sp > XB_SPIN_CAP) { atomicAdd(&bar[XB_TMO], 1u); break; } }
    }
    nloc = mine > 0u ? mine : 1u; nx = cnt > 0u ? cnt : 1u;
}
__device__ __forceinline__ void xcd_barrier(const XcdBarrier& b) {
    asm volatile("s_waitcnt vmcnt(0)" ::: "memory");
    __syncthreads();
    if (threadIdx.x == 0) {
        unsigned* bar = b.bar;
        __builtin_amdgcn_s_waitcnt(0);
        unsigned nloc = b.st[0], nx = b.st[1];
        if (nloc == 0u) { xcd_barrier_complete(bar, b.x, nloc, nx); b.st[0] = nloc; b.st[1] = nx; }
        const unsigned old = xb_add(&bar[XB_XSUB(b.x)], 1u);
        const unsigned gen = old / nloc;
        if (old + 1u == (gen + 1u) * nloc) {
            __builtin_amdgcn_fence(__ATOMIC_RELEASE, "agent");
            asm volatile("s_waitcnt vmcnt(0)" ::: "memory");
            const unsigned og = xb_add(&bar[XB_TOP], 1u);
            const unsigned tg = og / nx;
            if (og + 1u == (tg + 1u) * nx) xb_add(&bar[XB_TOPGEN], 1u);
            else XB_SPIN(xb_ld(&bar[XB_TOPGEN]) == tg, bar);
            __builtin_amdgcn_fence(__ATOMIC_ACQUIRE, "agent");
            xb_add(&bar[XB_XGEN(b.x)], 1u);
            asm volatile("s_waitcnt vmcnt(0)" ::: "memory");
        } else {
            XB_SPIN(xb_ld(&bar[XB_XGEN(b.x)]) == gen, bar);
            __builtin_amdgcn_fence(__ATOMIC_ACQUIRE, "agent");
            asm volatile("s_waitcnt vmcnt(0)" ::: "memory");
        }
    }
    __syncthreads();
}

using pg8::f32x4; using pg8::u32x4; using pg8::Unit; using pg8::pack8; using pg8::unpack8; using pg8::sigmoidf_;
typedef const f32x4 (&AccT)[2][2][4][2];

struct EpiSwiglu {
    static constexpr bool PERM = true;
    bf16* O; const float* ss;
    __device__ __forceinline__ void operator()(AccT acc, const Unit& u, int wr, int wc, int fr, int fq) const {
        bf16* Ou = O + (size_t)u.pm * 256 * FF + u.pn * 128; const float* ssu = ss + u.pm * 256;
        unsigned rl0 = wr * 64 + fr, c0 = wc * 32 + 8 * fq; asm volatile("" : "+v"(rl0), "+v"(c0));
#pragma unroll
        for (int ai = 0; ai < 2; ++ai)
#pragma unroll
            for (int m = 0; m < 4; ++m) {
                const unsigned rl = rl0 + ai * 128 + m * 16;
                const float rs = __builtin_amdgcn_rsqf(ssu[rl] * (1.0f / D) + RMS_EPS);
                f32x4 h[2];
#pragma unroll
                for (int n = 0; n < 2; ++n) { const f32x4 a = acc[ai][0][m][n] * rs, b = acc[ai][1][m][n] * rs;
#pragma unroll
                    for (int e = 0; e < 4; ++e) h[n][e] = a[e] * sigmoidf_(a[e]) * b[e]; }
                *(u32x4*)(Ou + (rl * FF + c0)) = pack8(h[0], h[1]);
            }
    }
};
struct EpiResid {
    static constexpr bool PERM = true;
    const float* base_p; const float* base_s; float* out; bf16* xb; float* ssn; float alpha;
    __device__ __forceinline__ void operator()(AccT acc, const Unit& u, int wr, int wc, int fr, int fq) const {
        const size_t uo = (size_t)u.pm * 256 * D + u.pn * 256;
        const float* bu = (u.pm < MP / 256) ? base_p + uo : base_s + u.pn * 256; float* ou = out + uo; bf16* xu = xb + uo; float* su = ssn + u.pm * 256;
        unsigned rl0 = wr * 64 + fr, c0 = wc * 32 + 8 * fq; asm volatile("" : "+v"(rl0), "+v"(c0));
#pragma unroll
        for (int ai = 0; ai < 2; ++ai) {
            f32x4 bv[4][2][2];
#pragma unroll
            for (int m = 0; m < 4; ++m)
#pragma unroll
                for (int bj = 0; bj < 2; ++bj) { const unsigned ro = (rl0 + ai * 128 + m * 16) * D + c0 + bj * 128; bv[m][bj][0] = *(const f32x4*)(bu + ro); bv[m][bj][1] = *(const f32x4*)(bu + (ro + 4)); }
#pragma unroll
            for (int m = 0; m < 4; ++m) {
                const unsigned rl = rl0 + ai * 128 + m * 16; const unsigned ro = rl * D + c0;
                float sq = 0.f;
#pragma unroll
                for (int bj = 0; bj < 2; ++bj) {
                    const f32x4 h0 = bv[m][bj][0] + acc[ai][bj][m][0] * alpha, h1 = bv[m][bj][1] + acc[ai][bj][m][1] * alpha;
                    *(f32x4*)(ou + (ro + bj * 128)) = h0; *(f32x4*)(ou + (ro + bj * 128 + 4)) = h1;
                    *(u32x4*)(xu + (ro + bj * 128)) = pack8(h0, h1);
                    sq += (h0[0] * h0[0] + h0[1] * h0[1]) + (h0[2] * h0[2] + h0[3] * h0[3]) + (h1[0] * h1[0] + h1[1] * h1[1]) + (h1[2] * h1[2] + h1[3] * h1[3]);
                }
                sq += __shfl_xor(sq, 16); sq += __shfl_xor(sq, 32);
                if (fq == 0) atomicAdd(su + rl, sq);
            }
        }
    }
};
struct EpiWin {
    static constexpr bool PERM = true;
    unsigned char* ws; const float* ss; const float* qn; const float* kn; float* dout; LAS float* xch;
    __device__ __forceinline__ void operator()(AccT acc, const Unit& u, int wr, int wc, int fr, int fq) const {
        const int pn = u.pn, pm = u.pm; unsigned rl0 = wr * 64 + fr, cw = wc * 32 + 8 * fq; asm volatile("" : "+v"(rl0), "+v"(cw));
        const float* ssu = ss + pm * 256;
        const bool samp = pm >= MP / 256; const int pb = pm >> 3, t0 = (pm & 7) * 256;
        if (pn < 4) {
            bf16* Zu = (bf16*)(ws + WS_ZB) + (size_t)pm * 256 * PW + pn * 256;
            float* so = samp ? dout + O_SPS + 7 * PW + pn * 256 : dout + O_SPP + ((size_t)pb * 15 + t0) * PW - (size_t)(T_P - 15) * PW + pn * 256;
#pragma unroll
            for (int ai = 0; ai < 2; ++ai)
#pragma unroll
                for (int m = 0; m < 4; ++m) {
                    const unsigned rl = rl0 + ai * 128 + m * 16; const float rs = __builtin_amdgcn_rsqf(ssu[rl] * (1.0f / D) + RMS_EPS);
                    const bool keep = samp || (t0 + (int)rl >= T_P - 15);
                    const unsigned sofs = samp ? ((rl >> 3) * 15 + (rl & 7)) * PW + cw : rl * PW + cw;
#pragma unroll
                    for (int bj = 0; bj < 2; ++bj) {
                        const f32x4 v0 = acc[ai][bj][m][0] * rs, v1 = acc[ai][bj][m][1] * rs;
                        *(u32x4*)(Zu + (rl * PW + bj * 128 + cw)) = pack8(v0, v1);
                        if (keep) { *(f32x4*)(so + (sofs + bj * 128)) = v0; *(f32x4*)(so + (sofs + bj * 128 + 4)) = v1; } }
                }
        } else if (pn < 28) {
            const bool isk = pn >= 16; const int hh0 = 2 * (isk ? pn - 16 : pn - 4);
            const float* gn = isk ? kn : qn;
            const f32x4 g0 = *(const f32x4*)(gn + cw), g1 = *(const f32x4*)(gn + cw + 4);
            float rsv[2][4];
#pragma unroll
            for (int ai = 0; ai < 2; ++ai)
#pragma unroll
                for (int m = 0; m < 4; ++m) {
                    const unsigned rl = rl0 + ai * 128 + m * 16; const float rs = __builtin_amdgcn_rsqf(ssu[rl] * (1.0f / D) + RMS_EPS); rsv[ai][m] = rs;
#pragma unroll
                    for (int bj = 0; bj < 2; ++bj) { const f32x4 v0 = acc[ai][bj][m][0] * rs, v1 = acc[ai][bj][m][1] * rs;
                        float sq = (v0[0] * v0[0] + v0[1] * v0[1]) + (v0[2] * v0[2] + v0[3] * v0[3]) + (v1[0] * v1[0] + v1[1] * v1[1]) + (v1[2] * v1[2] + v1[3] * v1[3]);
                        sq += __shfl_xor(sq, 16); sq += __shfl_xor(sq, 32);
                        if (fq == 0) xch[(rl * 2 + bj) * 4 + wc] = sq; }
                }
            asm volatile("s_waitcnt lgkmcnt(0)" ::: "memory"); __builtin_amdgcn_s_barrier(); asm volatile("" ::: "memory");
            bf16* Ou = (bf16*)(ws + (isk ? WS_KB : WS_QB)) + (size_t)pm * 256 * QKVW + hh0 * HD;
            const int g = hh0 >> 3, h0 = hh0 & 7; const int keepn = (g == 0) ? 128 : (g == 1 ? 512 : 2048);
            float* co = samp ? dout + (g == 0 ? O_K0S : (g == 1 ? O_K1S : O_K2S)) + ((size_t)(keepn - 8) * 8 + h0) * HD
                             : dout + (g == 0 ? O_K0P : (g == 1 ? O_K1P : O_K2P)) + (((size_t)pb * keepn + t0) * 8 + h0) * HD - (size_t)(T_P - keepn) * 8 * HD;
#pragma unroll
            for (int ai = 0; ai < 2; ++ai)
#pragma unroll
                for (int m = 0; m < 4; ++m) {
                    const unsigned rl = rl0 + ai * 128 + m * 16; const float rs = rsv[ai][m];
                    const bool keep = isk && (samp || (t0 + (int)rl >= T_P - keepn));
                    const unsigned cofs = samp ? ((rl >> 3) * keepn + (rl & 7)) * 1024 + cw : rl * 1024 + cw;
#pragma unroll
                    for (int bj = 0; bj < 2; ++bj) {
                        const f32x4 pz = *(const LAS f32x4*)(xch + (rl * 2 + bj) * 4);
                        const float rn = rs * __builtin_amdgcn_rsqf(((pz[0] + pz[1]) + (pz[2] + pz[3])) * (1.0f / HD) + RMS_EPS);
                        const f32x4 v0 = acc[ai][bj][m][0] * rn * g0, v1 = acc[ai][bj][m][1] * rn * g1;
                        *(u32x4*)(Ou + (rl * QKVW + bj * HD + cw)) = pack8(v0, v1);
                        if (keep) { *(f32x4*)(co + (cofs + bj * HD)) = v0; *(f32x4*)(co + (cofs + bj * HD + 4)) = v1; }
                    }
                }
        } else if (pn < 40) {
            const int hh0 = 2 * (pn - 28);
            bf16* Ou = (bf16*)(ws + WS_VB) + (size_t)pm * 256 * QKVW + hh0 * HD;
            const int g = hh0 >> 3, h0 = hh0 & 7; const int keepn = (g == 0) ? 128 : (g == 1 ? 512 : 2048);
            float* co = samp ? dout + (g == 0 ? O_V0S : (g == 1 ? O_V1S : O_V2S)) + ((size_t)(keepn - 8) * 8 + h0) * HD
                             : dout + (g == 0 ? O_V0P : (g == 1 ? O_V1P : O_V2P)) + (((size_t)pb * keepn + t0) * 8 + h0) * HD - (size_t)(T_P - keepn) * 8 * HD;
#pragma unroll
            for (int ai = 0; ai < 2; ++ai)
#pragma unroll
                for (int m = 0; m < 4; ++m) {
                    const unsigned rl = rl0 + ai * 128 + m * 16; const float rs = __builtin_amdgcn_rsqf(ssu[rl] * (1.0f / D) + RMS_EPS);
                    const bool keep = samp || (t0 + (int)rl >= T_P - keepn);
                    const unsigned cofs = samp ? ((rl >> 3) * keepn + (rl & 7)) * 1024 + cw : rl * 1024 + cw;
#pragma unroll
                    for (int bj = 0; bj < 2; ++bj) {
                        const f32x4 v0 = acc[ai][bj][m][0] * rs, v1 = acc[ai][bj][m][1] * rs;
                        *(u32x4*)(Ou + (rl * QKVW + bj * HD + cw)) = pack8(v0, v1);
                        if (keep) { *(f32x4*)(co + (cofs + bj * HD)) = v0; *(f32x4*)(co + (cofs + bj * HD + 4)) = v1; }
                    }
                }
        } else {
            bf16* Gu = (bf16*)(ws + WS_GB) + (size_t)pm * 256 * 4096 + (pn - 40) * 256;
#pragma unroll
            for (int ai = 0; ai < 2; ++ai)
#pragma unroll
                for (int m = 0; m < 4; ++m) {
                    const unsigned rl = rl0 + ai * 128 + m * 16; const float rs = __builtin_amdgcn_rsqf(ssu[rl] * (1.0f / D) + RMS_EPS);
#pragma unroll
                    for (int bj = 0; bj < 2; ++bj) {
                        f32x4 v0 = acc[ai][bj][m][0] * rs, v1 = acc[ai][bj][m][1] * rs;
#pragma unroll
                        for (int e = 0; e < 4; ++e) { v0[e] = sigmoidf_(v0[e]); v1[e] = sigmoidf_(v1[e]); }
                        *(u32x4*)(Gu + (rl * 4096 + bj * 128 + cw)) = pack8(v0, v1); }
                }
        }
    }
};
struct EpiScaleCol {
    static constexpr bool PERM = true;
    bf16* O; int ldc; const float* scale;
    __device__ __forceinline__ void operator()(AccT acc, const Unit& u, int wr, int wc, int fr, int fq) const {
        bf16* Ou = O + (size_t)u.pm * 256 * ldc + u.pn * 256;
        unsigned rl0 = wr * 64 + fr, c0 = wc * 32 + 8 * fq; asm volatile("" : "+v"(rl0), "+v"(c0));
        f32x4 s[2][2];
#pragma unroll
        for (int bj = 0; bj < 2; ++bj)
#pragma unroll
            for (int n = 0; n < 2; ++n) s[bj][n] = scale ? *(const f32x4*)(scale + u.pn * 256 + (c0 + bj * 128 + 4 * n)) : (f32x4){1.f, 1.f, 1.f, 1.f};
#pragma unroll
        for (int ai = 0; ai < 2; ++ai)
#pragma unroll
            for (int m = 0; m < 4; ++m) { const unsigned rl = rl0 + ai * 128 + m * 16;
#pragma unroll
                for (int bj = 0; bj < 2; ++bj) *(u32x4*)(Ou + (rl * (unsigned)ldc + c0 + bj * 128)) = pack8(acc[ai][bj][m][0] * s[bj][0], acc[ai][bj][m][1] * s[bj][1]); }
    }
};
template <bool ADD> struct EpiGate {
    static constexpr bool PERM = true;
    bf16* MBp; const bf16* GBp; int goff;
    __device__ __forceinline__ void operator()(AccT acc, const Unit& u, int wr, int wc, int fr, int fq) const {
        bf16* Mu = MBp + (size_t)u.pm * 256 * D + u.pn * 256; const bf16* Gu = GBp + (size_t)u.pm * 256 * 4096 + goff + u.pn * 256;
        unsigned rl0 = wr * 64 + fr, c0 = wc * 32 + 8 * fq; asm volatile("" : "+v"(rl0), "+v"(c0));
#pragma unroll
        for (int ai = 0; ai < 2; ++ai) {
            u32x4 gv[4][2], mv[4][2];
#pragma unroll
            for (int m = 0; m < 4; ++m)
#pragma unroll
                for (int bj = 0; bj < 2; ++bj) { const unsigned rl = rl0 + ai * 128 + m * 16; gv[m][bj] = *(const u32x4*)(Gu + (rl * 4096 + c0 + bj * 128));
                    if (ADD) mv[m][bj] = *(const u32x4*)(Mu + (rl * D + c0 + bj * 128)); }
#pragma unroll
            for (int m = 0; m < 4; ++m) { const unsigned rl = rl0 + ai * 128 + m * 16;
#pragma unroll
                for (int bj = 0; bj < 2; ++bj) {
                    f32x4 g0, g1; unpack8(gv[m][bj], g0, g1);
                    f32x4 r0 = g0 * acc[ai][bj][m][0], r1 = g1 * acc[ai][bj][m][1];
                    if (ADD) { f32x4 p0, p1; unpack8(mv[m][bj], p0, p1); r0 += p0; r1 += p1; }
                    *(u32x4*)(Mu + (rl * D + c0 + bj * 128)) = pack8(r0, r1); } }
        }
    }
};
struct EpiFinal {
    static constexpr bool PERM = true;
    float* out; const bf16* PPp; const float* ss;
    __device__ __forceinline__ void operator()(AccT acc, const Unit& u, int wr, int wc, int fr, int fq) const {
        const size_t uo = (size_t)u.pm * 256 * D + u.pn * 256; float* ou = out + uo; const bf16* pu = PPp + uo; const float* ssu = ss + u.pm * 256;
        unsigned rl0 = wr * 64 + fr, c0 = wc * 32 + 8 * fq; asm volatile("" : "+v"(rl0), "+v"(c0));
        float ssv[2][4];
#pragma unroll
        for (int ai = 0; ai < 2; ++ai)
#pragma unroll
            for (int m = 0; m < 4; ++m) ssv[ai][m] = ssu[rl0 + ai * 128 + m * 16];
#pragma unroll
        for (int ai = 0; ai < 2; ++ai)
#pragma unroll
            for (int mp = 0; mp < 4; mp += 2) {
                u32x4 pv[2][2]; f32x4 hv[2][2][2];
#pragma unroll
                for (int mm = 0; mm < 2; ++mm)
#pragma unroll
                    for (int bj = 0; bj < 2; ++bj) { const unsigned o = (rl0 + ai * 128 + (mp + mm) * 16) * D + c0 + bj * 128;
                        pv[mm][bj] = *(const u32x4*)(pu + o); hv[mm][bj][0] = *(const f32x4*)(ou + o); hv[mm][bj][1] = *(const f32x4*)(ou + (o + 4)); }
#pragma unroll
                for (int mm = 0; mm < 2; ++mm) { const int m = mp + mm; const float rs = __builtin_amdgcn_rsqf(ssv[ai][m] * (1.0f / D) + RMS_EPS);
#pragma unroll
                    for (int bj = 0; bj < 2; ++bj) { const unsigned o = (rl0 + ai * 128 + m * 16) * D + c0 + bj * 128;
                        f32x4 p0, p1; unpack8(pv[mm][bj], p0, p1);
                        f32x4 h0 = hv[mm][bj][0], h1 = hv[mm][bj][1];
                        const f32x4 a0 = acc[ai][bj][m][0] * rs, a1 = acc[ai][bj][m][1] * rs;
#pragma unroll
                        for (int e = 0; e < 4; ++e) { h0[e] += sigmoidf_(a0[e]) * p0[e]; h1[e] += sigmoidf_(a1[e]) * p1[e]; }
                        *(f32x4*)(ou + o) = h0; *(f32x4*)(ou + (o + 4)) = h1; } }
            }
    }
};

struct Frame {
    LAS unsigned char* lds; volatile LAS unsigned* MISC; gu32* ctl;
    int tid, lane, wave, G, gw, NGW;
    unsigned char* ws; float* out;
};
struct Args { const float* in[29]; float* out; unsigned char* ws; int ph_lo, ph_hi, li, pad; };
enum { I_XP = 0, I_XS, I_PP, I_PS, I_SPOOL, I_CK0, I_CV0, I_CK1, I_CV1, I_CK2, I_CV2, I_F1N, I_F1WI, I_F1WO, I_MIXN, I_WIN, I_QN, I_KN, I_PMAP, I_PSCALE, I_WPO, I_WAO, I_WO,
       I_F2N, I_F2WI, I_F2WO, I_PLEN, I_PLEG, I_PLEP };

template <class T> __device__ __forceinline__ T* opaque_ptr(T* p) { size_t z = 0; asm volatile("" : "+s"(z)); return (T*)((unsigned char*)p + z); }
__device__ __forceinline__ float wave_sum(float v) {
#pragma unroll
    for (int o = 1; o < 64; o <<= 1) v += __shfl_xor(v, o);
    return v;
}
__device__ __forceinline__ float wave_max(float v) {
#pragma unroll
    for (int o = 1; o < 64; o <<= 1) v = fmaxf(v, __shfl_xor(v, o));
    return v;
}
template <int MODE>
__device__ __forceinline__ void transpose_item(const float* W, int K, int N, bf16* WT, const float* gain, LAS float* scr, int item, int lane) {
    const int nblk = N / 32, kb = item / nblk, nb = item % nblk, k0 = 64 * kb, n0 = 32 * nb;
    float wv[32];
#pragma unroll
    for (int i = 0; i < 32; ++i) { const int kk = 2 * i + (lane >> 5); wv[i] = W[(size_t)(k0 + kk) * N + n0 + (lane & 31)]; }
    if (gain) {
#pragma unroll
        for (int i = 0; i < 32; ++i) wv[i] *= gain[k0 + 2 * i + (lane >> 5)]; }
#pragma unroll
    for (int i = 0; i < 32; ++i) scr[(2 * i + (lane >> 5)) * 33 + (lane & 31)] = wv[i];
    LDS_WAIT(); asm volatile("" ::: "memory");
    const int c = lane & 7;
    int r0 = n0;
    if (MODE == 1) { const int isb = n0 >= FF ? 1 : 0, j = n0 - isb * FF; r0 = 256 * (j >> 7) + 128 * isb + (j & 127); }
#pragma unroll
    for (int j = 0; j < 4; ++j) { const int n = (lane >> 3) + 8 * j; const LAS float* s = scr + (8 * c) * 33 + n;
        v4u o; o.x = pk2(s[0 * 33], s[1 * 33]); o.y = pk2(s[2 * 33], s[3 * 33]); o.z = pk2(s[4 * 33], s[5 * 33]); o.w = pk2(s[6 * 33], s[7 * 33]);
        *(GAS v4u*)(WT + (size_t)(r0 + n) * K + k0 + 8 * c) = o; }
    LDS_WAIT(); asm volatile("" ::: "memory");
}

__device__ __forceinline__ void p0_prologue(Frame& F, const Args& a) {
    LAS float* scr = (LAS float*)(F.lds + RING_OFF + F.wave * 16384);
    unsigned char* ws = opaque_ptr(F.ws); float* const dout = opaque_ptr(F.out);
    {
        const int n1 = (D / 64) * (2 * FF / 32), n2 = (FF / 64) * (D / 32), n3 = (D / 64) * (INW / 32), n4 = 4 * (256 / 64) * (256 / 32), n5 = (PW / 64) * (D / 32), n6 = n5,
                  n7 = (D / 64) * (D / 32), n8 = n1, n9 = n2, n10 = n7, n11 = (DPLE / 64) * (D / 32);
        const int total = n1 + n2 + n3 + n4 + n5 + n6 + n7 + n8 + n9 + n10 + n11;
        for (int it = F.gw; it < total; it += F.NGW) {
            int r = it;
            if (r < n1) { transpose_item<1>(a.in[I_F1WI], D, 2 * FF, (bf16*)(ws + WS_W1T), a.in[I_F1N], scr, r, F.lane); continue; } r -= n1;
            if (r < n2) { transpose_item<0>(a.in[I_F1WO], FF, D, (bf16*)(ws + WS_W2T), nullptr, scr, r, F.lane); continue; } r -= n2;
            if (r < n3) { transpose_item<0>(a.in[I_WIN], D, INW, (bf16*)(ws + WS_WINT), a.in[I_MIXN], scr, r, F.lane); continue; } r -= n3;
            if (r < n4) { const int g = r / 32, rr = r % 32; transpose_item<0>(a.in[I_PMAP] + (size_t)g * 65536, 256, 256, (bf16*)(ws + WS_PMT) + (size_t)g * 65536, nullptr, scr, rr, F.lane); continue; } r -= n4;
            if (r < n5) { transpose_item<0>(a.in[I_WPO], PW, D, (bf16*)(ws + WS_WPOT), nullptr, scr, r, F.lane); continue; } r -= n5;
            if (r < n6) { transpose_item<0>(a.in[I_WAO], PW, D, (bf16*)(ws + WS_WAOT), nullptr, scr, r, F.lane); continue; } r -= n6;
            if (r < n7) { transpose_item<0>(a.in[I_WO], D, D, (bf16*)(ws + WS_WOT), nullptr, scr, r, F.lane); continue; } r -= n7;
            if (r < n8) { transpose_item<1>(a.in[I_F2WI], D, 2 * FF, (bf16*)(ws + WS_W3T), a.in[I_F2N], scr, r, F.lane); continue; } r -= n8;
            if (r < n9) { transpose_item<0>(a.in[I_F2WO], FF, D, (bf16*)(ws + WS_W4T), nullptr, scr, r, F.lane); continue; } r -= n9;
            if (r < n10) { transpose_item<0>(a.in[I_PLEG], D, D, (bf16*)(ws + WS_PGT), a.in[I_PLEN], scr, r, F.lane); continue; } r -= n10;
            transpose_item<0>(a.in[I_PLEP], DPLE, D, (bf16*)(ws + WS_PPT), nullptr, scr, r, F.lane);
        }
    }
    {
        bf16* XB = (bf16*)(ws + WS_XB); float* ss0 = (float*)(ws + WS_SS0); bf16* PB = (bf16*)(ws + WS_PB);
        for (int m = F.gw; m < M; m += F.NGW) {
            const float* xr = (m < MP) ? a.in[I_XP] + (size_t)m * D : a.in[I_XS] + (size_t)(m - MP) * D;
            const GAS f32x4* xv = (const GAS f32x4*)xr + F.lane;
            f32x4 v[8]; float s = 0.f;
#pragma unroll
            for (int j = 0; j < 8; ++j) { v[j] = xv[64 * j]; s += (v[j].x * v[j].x + v[j].y * v[j].y) + (v[j].z * v[j].z + v[j].w * v[j].w); }
            s = wave_sum(s);
            GAS v2u* o8 = (GAS v2u*)(XB + (size_t)m * D) + F.lane;
#pragma unroll
            for (int j = 0; j < 8; ++j) { v2u w; w.x = pk2(v[j].x, v[j].y); w.y = pk2(v[j].z, v[j].w); o8[64 * j] = w; }
            if (F.lane == 0) ss0[m] = s;
            const float* pr = (m < MP) ? a.in[I_PP] + (size_t)m * DPLE : a.in[I_PS] + (size_t)(m - MP) * DPLE;
            const f32x4 pv = ((const GAS f32x4*)pr)[F.lane];
            v2u w; w.x = pk2(pv.x, pv.y); w.y = pk2(pv.z, pv.w); ((GAS v2u*)(PB + (size_t)m * DPLE))[F.lane] = w;
        }
    }
    {
        const unsigned gt = blockIdx.x * 512u + (unsigned)F.tid, NT = (unsigned)F.G * 512u;
#pragma unroll 1
        for (int c = 0; c < 6; ++c) {
            const int g = c >> 1; const int L = (g == 0) ? 128 : (g == 1 ? 512 : 2048);
            const float* src = a.in[I_CK0 + c];
            float* dst = dout + ((c == 0) ? O_K0S : (c == 1) ? O_V0S : (c == 2) ? O_K1S : (c == 3) ? O_V1S : (c == 4) ? O_K2S : O_V2S);
            const unsigned per_b = (unsigned)(L - 8) * 256u;
#pragma unroll 1
            for (int b = 0; b < NB_S; ++b) {
                const f32x4* sp = (const f32x4*)(src + (size_t)b * L * 1024 + 8192); f32x4* dp = (f32x4*)(dst + (size_t)b * L * 1024);
                for (unsigned r = gt; r < per_b; r += 8u * NT) { f32x4 v[8];
#pragma unroll
                    for (int k = 0; k < 8; ++k) if (r + k * NT < per_b) v[k] = __builtin_nontemporal_load(sp + (r + k * NT));
#pragma unroll
                    for (int k = 0; k < 8; ++k) if (r + k * NT < per_b) __builtin_nontemporal_store(v[k], dp + (r + k * NT)); }
            }
        }
        const unsigned total = (unsigned)NB_S * 7u * 256u;
        for (unsigned i = gt; i < total; i += NT) { const unsigned b = i / (7u * 256u), r = i - b * (7u * 256u);
            ((f32x4*)(dout + O_SPS + (size_t)b * 15 * 1024))[r] = ((const f32x4*)(a.in[I_SPOOL] + (size_t)b * 15 * 1024 + 8 * 1024))[r]; }
    }
}

__device__ __forceinline__ void pooling_phase(Frame& F, const Args& a) {
    unsigned char* ws = opaque_ptr(F.ws);
    const bf16* ZB = (const bf16*)(ws + WS_ZB); bf16* PO = (bf16*)(ws + WS_POOLED);
    const unsigned gt = blockIdx.x * 512u + (unsigned)F.tid, NT = (unsigned)F.G * 512u;
    for (unsigned task = gt; task < (unsigned)(NB_P * (T_P / 32) * 128); task += NT) {
        const unsigned c8 = task & 127, seg = (task >> 7) & 63, b = task >> 13; const unsigned col = c8 * 8; const int w = 2 << (c8 >> 5);
        const int t0 = (int)seg * 32; const bf16* zb = ZB + ((size_t)b * T_P) * PW + col; bf16* pb = PO + ((size_t)b * T_P) * PW + col;
        float s[8];
#pragma unroll
        for (int e = 0; e < 8; ++e) s[e] = 0.f;
        {
            u32x4 pre[16];
#pragma unroll
            for (int j = 0; j < 16; ++j) { const int t = t0 - 1 - j; pre[j] = (j < w && t >= 0) ? *(const u32x4*)(zb + (unsigned)t * PW) : (u32x4){0u, 0u, 0u, 0u}; }
#pragma unroll
            for (int j = 0; j < 16; ++j) { f32x4 a0, a1; unpack8(pre[j], a0, a1);
#pragma unroll
                for (int e = 0; e < 4; ++e) { s[e] += a0[e]; s[4 + e] += a1[e]; } }
        }
#pragma unroll 1
        for (int tt = 0; tt < 32; tt += 8) {
            u32x4 nw[8], od[8];
#pragma unroll
            for (int k = 0; k < 8; ++k) { const int t = t0 + tt + k; nw[k] = *(const u32x4*)(zb + (unsigned)t * PW); od[k] = (t - w >= 0) ? *(const u32x4*)(zb + (unsigned)(t - w) * PW) : (u32x4){0u, 0u, 0u, 0u}; }
#pragma unroll
            for (int k = 0; k < 8; ++k) { const int t = t0 + tt + k; f32x4 n0, n1, o0, o1; unpack8(nw[k], n0, n1); unpack8(od[k], o0, o1);
                const float ic = 1.0f / (float)((t + 1 < w) ? t + 1 : w);
                f32x4 r0, r1;
#pragma unroll
                for (int e = 0; e < 4; ++e) { s[e] += n0[e] - o0[e]; s[4 + e] += n1[e] - o1[e]; r0[e] = s[e] * ic - n0[e]; r1[e] = s[4 + e] * ic - n1[e]; }
                *(u32x4*)(pb + (unsigned)t * PW) = pack8(r0, r1); }
        }
    }
    for (unsigned idx = gt; idx < (unsigned)(MS * 128); idx += NT) {
        const int r = (int)(idx >> 7), c8 = (int)(idx & 127), col = c8 * 8, row = MP + r, b = r >> 3, i = r & 7;
        const int w = 2 << (c8 >> 5);
        float s[8];
#pragma unroll
        for (int e = 0; e < 8; ++e) s[e] = 0.f;
        f32x4 z0, z1; unpack8(*(const u32x4*)(ZB + (size_t)row * PW + col), z0, z1);
        for (int j = 0; j < w; ++j) { const int e_ = 15 + i - j;
            f32x4 a0, a1;
            if (e_ >= 15) unpack8(*(const u32x4*)(ZB + (size_t)(MP + b * 8 + (e_ - 15)) * PW + col), a0, a1);
            else { const float* sp = a.in[I_SPOOL] + ((size_t)b * 15 + e_) * PW + col; a0 = *(const f32x4*)sp; a1 = *(const f32x4*)(sp + 4); }
#pragma unroll
            for (int e = 0; e < 4; ++e) { s[e] += a0[e]; s[4 + e] += a1[e]; } }
        const float ic = 1.0f / (float)w;
        f32x4 o0, o1;
#pragma unroll
        for (int e = 0; e < 4; ++e) { o0[e] = s[e] * ic - z0[e]; o1[e] = s[4 + e] * ic - z1[e]; }
        *(u32x4*)(PO + (size_t)row * PW + col) = pack8(o0, o1);
    }
}

__device__ __forceinline__ void merge_phase(Frame& F) {
    unsigned char* ws = opaque_ptr(F.ws);
    const bf16* OG = (const bf16*)(ws + WS_QB); const float* LSE = (const float*)(ws + WS_LSE); bf16* OA = (bf16*)(ws + WS_OATT);
    const size_t gt = (size_t)blockIdx.x * 512 + F.tid, NT = (size_t)F.G * 512;
    const size_t total = (size_t)M * 128;
    for (size_t idx = gt; idx < total; idx += NT) {
        const int row = (int)(idx >> 7), c8 = (int)(idx & 127), h = c8 >> 4, col = c8 * 8;
        const float l0 = LSE[(size_t)row * 24 + h], l1 = LSE[(size_t)row * 24 + 8 + h], l2 = LSE[(size_t)row * 24 + 16 + h];
        const float mx = fmaxf(l0, fmaxf(l1, l2));
        float w0 = __expf(l0 - mx), w1 = __expf(l1 - mx), w2 = __expf(l2 - mx); const float inv = 1.0f / (w0 + w1 + w2); w0 *= inv; w1 *= inv; w2 *= inv;
        f32x4 a0, a1, b0, b1, c0, c1;
        unpack8(*(const u32x4*)(OG + (size_t)row * QKVW + col), a0, a1);
        unpack8(*(const u32x4*)(OG + (size_t)row * QKVW + 1024 + col), b0, b1);
        unpack8(*(const u32x4*)(OG + (size_t)row * QKVW + 2048 + col), c0, c1);
        *(u32x4*)(OA + (size_t)row * PW + col) = pack8(a0 * w0 + b0 * w1 + c0 * w2, a1 * w0 + b1 * w1 + c1 * w2);
    }
}

__device__ __forceinline__ void sample_attn_phase(Frame& F, const Args& a) {
    unsigned char* ws = opaque_ptr(F.ws); float* const dout = opaque_ptr(F.out);
    bf16* QB = (bf16*)(ws + WS_QB); float* LSE = (float*)(ws + WS_LSE);
    const int lane = F.lane;
#pragma unroll 1
    for (int task = F.gw; task < NB_S * T_S * 24; task += F.NGW) {
        const int hh = task % 24, bi = task / 24, b = bi >> 3, i = bi & 7, g = hh >> 3, h = hh & 7;
        const int row = MP + bi;
        const int dil = 1 << (2 * g), L = 128 << (2 * g);
        const float* ck = a.in[I_CK0 + 2 * g]; const float* cv = a.in[I_CV0 + 2 * g];
        const size_t no = (g == 0 ? O_K0S : (g == 1 ? O_K1S : O_K2S)); const size_t vo_ = (g == 0 ? O_V0S : (g == 1 ? O_V1S : O_V2S));
        const float* nk = dout + no; const float* nv = dout + vo_;
        bf16* qp = QB + (size_t)row * QKVW + hh * HD + 2 * lane;
        const unsigned qw = *(const unsigned*)qp;
        const float q0 = pg8::bf_lo(qw), q1 = pg8::bf_hi(qw);
        const float slope = __builtin_amdgcn_exp2f(-(float)(h + 1));
        const size_t hb = (size_t)h * HD + 2 * lane;
        float sc0 = -1e30f, sc1 = -1e30f, sc2 = -1e30f;
#pragma unroll 1
        for (int j0 = 0; j0 < 160; j0 += 32) {
            f32x2 kv[32];
#pragma unroll
            for (int jj = 0; jj < 32; ++jj) { const int j = j0 + jj; const int jc = j < 129 ? j : 128; const int e_ = L + i - jc * dil;
                const float* kp = (e_ < L) ? ck + ((size_t)b * L + e_) * 1024 : nk + ((size_t)b * L + (e_ - 8)) * 1024;
                kv[jj] = *(const f32x2*)(kp + hb); }
#pragma unroll
            for (int jj = 0; jj < 32; ++jj) { const int j = j0 + jj;
                float d = wave_sum(kv[jj].x * q0 + kv[jj].y * q1);
                d = d * 0.08838834764831845f - slope * (float)(j * dil);
                if (j < 129 && lane == (j & 63)) { if ((j >> 6) == 0) sc0 = d; else if ((j >> 6) == 1) sc1 = d; else sc2 = d; } }
        }
        const float mx = wave_max(fmaxf(sc0, fmaxf(sc1, sc2)));
        const float p0 = __expf(sc0 - mx), p1 = __expf(sc1 - mx), p2 = __expf(sc2 - mx);
        const float den = wave_sum(p0 + p1 + p2);
        float o0 = 0.f, o1 = 0.f;
#pragma unroll 1
        for (int j0 = 0; j0 < 160; j0 += 32) {
            f32x2 vv[32];
#pragma unroll
            for (int jj = 0; jj < 32; ++jj) { const int j = j0 + jj; const int jc = j < 129 ? j : 128; const int e_ = L + i - jc * dil;
                const float* vp = (e_ < L) ? cv + ((size_t)b * L + e_) * 1024 : nv + ((size_t)b * L + (e_ - 8)) * 1024;
                vv[jj] = *(const f32x2*)(vp + hb); }
#pragma unroll
            for (int jj = 0; jj < 32; ++jj) { const int j = j0 + jj;
                const float psel = (j >> 6) == 0 ? p0 : ((j >> 6) == 1 ? p1 : p2);
                const float pj = (j < 129) ? __shfl(psel, j & 63) : 0.f;
                o0 += pj * vv[jj].x; o1 += pj * vv[jj].y; }
        }
        const float id = 1.0f / den;
        *(unsigned*)qp = pk2(o0 * id, o1 * id);
        if (lane == 0) LSE[(size_t)row * 24 + hh] = mx + __logf(den);
    }
}

__device__ __forceinline__ unsigned off_b(unsigned row, unsigned ch) { return 256u * row + 16u * (ch ^ (((row & 3) << 2) | ((row >> 2) & 3))); }
__device__ __forceinline__ void glds16(const void* gsrc, unsigned lds_dst) { unsigned keep;
    asm volatile("s_mov_b32 %0, m0\n\ts_mov_b32 m0, %2\n\ts_nop 0\n\tglobal_load_lds_dwordx4 %1, off\n\ts_mov_b32 m0, %0" : "=&s"(keep) : "v"(gsrc), "s"(lds_dst) : "memory"); }
struct AttnUnit { int b, hh, h, dsh, cls, blk; };
__device__ __forceinline__ AttnUnit attn_decode(int un) {
    AttnUnit u; const int bgh = un >> 4, sub = un & 15; u.b = bgh / 24; u.hh = bgh % 24; const int g = u.hh >> 3; u.h = u.hh & 7; u.dsh = 2 * g;
    u.cls = sub >> (4 - u.dsh); u.blk = sub & ((16 >> u.dsh) - 1); return u;
}
__device__ __forceinline__ void attn_stage(const bf16* base, LAS unsigned char* slot, const AttnUnit& u, int w, int lane) {
    const size_t rowbase = (size_t)u.b * T_P;
#pragma unroll
    for (int c8 = 0; c8 < 8; ++c8) {
        const int c = w * 8 + c8; const int kr = 4 * c + (lane >> 4); const unsigned lc = (unsigned)(lane & 15) ^ (unsigned)(((lane >> 4) << 2) | (c8 & 3));
        int mk = 128 * (u.blk - 1) + kr; mk = mk < 0 ? 0 : mk;
        const size_t tok = rowbase + ((size_t)mk << u.dsh) + u.cls;
        glds16(base + tok * QKVW + u.hh * HD + 8 * lc, (unsigned)(unsigned long long)(slot + 1024 * c));
    }
}
__device__ __forceinline__ void attn_phase(Frame& F) {
    unsigned char* ws = opaque_ptr(F.ws);
    const bf16* KB = (const bf16*)(ws + WS_KB); const bf16* VB = (const bf16*)(ws + WS_VB); bf16* QB = (bf16*)(ws + WS_QB); float* LSE = (float*)(ws + WS_LSE);
    LAS unsigned char* Kt = F.lds + RING_OFF; LAS unsigned char* Vt = F.lds + RING_OFF + 65536;
    const int lane = F.lane, w = F.wave, i16 = lane & 15, g4 = lane >> 4;
    const int NUNITS = NB_P * 24 * 16;
    const int per = (NUNITS + F.G - 1) / F.G;
    const int u_lo = blockIdx.x * per, u_hi = (u_lo + per < NUNITS) ? u_lo + per : NUNITS;
    if (u_lo >= u_hi) return;
    const int T0 = w >> 1;
    int un = u_lo;
    AttnUnit cu = attn_decode(un);
    __syncthreads();
    attn_stage(KB, Kt, cu, w, lane);
    bf16x8 q0, q1, q2, q3;
#define ATTN_QLOAD(u_) do { const int mq_ = 128 * (u_).blk + 16 * w + i16; const size_t qt_ = (size_t)(u_).b * T_P + ((size_t)mq_ << (u_).dsh) + (u_).cls; \
        const bf16* qa_ = QB + qt_ * QKVW + (u_).hh * HD + 8 * g4; \
        asm volatile("global_load_dwordx4 %0, %4, off\n\tglobal_load_dwordx4 %1, %4, off offset:64\n\tglobal_load_dwordx4 %2, %4, off offset:128\n\tglobal_load_dwordx4 %3, %4, off offset:192" \
                     : "=&v"(q0), "=&v"(q1), "=&v"(q2), "=&v"(q3) : "v"(qa_) : "memory"); } while (0)
    ATTN_QLOAD(cu);
    attn_stage(VB, Vt, cu, w, lane);
    for (;;) {
        const bool has_next = (un + 1 < u_hi);
        const AttnUnit nu = attn_decode(has_next ? un + 1 : un);
        const int blk = cu.blk, h = cu.h, hh = cu.hh; const int dil = 1 << cu.dsh;
        const int mq = 128 * blk + 16 * w + i16; const size_t qtok = (size_t)cu.b * T_P + ((size_t)mq << cu.dsh) + cu.cls;
        asm volatile("s_waitcnt vmcnt(8)" : "+v"(q0), "+v"(q1), "+v"(q2), "+v"(q3) :: "memory"); __builtin_amdgcn_s_barrier(); asm volatile("" ::: "memory");
        const bf16x8 qf[4] = {q0, q1, q2, q3};
        unsigned ka0 = off_b(32u * T0 + 8u * (i16 >> 2) + (i16 & 3), g4);
        asm volatile("" : "+v"(ka0));
        f32x4 S[5][2];
#pragma unroll
        for (int T = 0; T < 5; ++T)
#pragma unroll
            for (int u = 0; u < 2; ++u) {
                S[T][u] = (f32x4){0.f, 0.f, 0.f, 0.f};
#pragma unroll
                for (int ks = 0; ks < 4; ++ks) { const bf16x8 kf = *(const LAS bf16x8*)(Kt + ((ka0 ^ (unsigned)((ks << 6) | (u << 4))) + 1024u * u + 8192u * T));
                    S[T][u] = __builtin_amdgcn_mfma_f32_16x16x32_bf16(kf, qf[ks], S[T][u], 0, 0, 0); }
            }
        asm volatile("" ::: "memory"); __builtin_amdgcn_s_barrier(); asm volatile("" ::: "memory");
        if (has_next) { attn_stage(KB, Kt, nu, w, lane); ATTN_QLOAD(nu); }
        asm volatile("" ::: "memory");
        const float c1 = 0.08838834764831845f * 1.4426950408889634f;
        const float c2 = __builtin_amdgcn_exp2f(-(float)(h + 1)) * (float)dil * 1.4426950408889634f;
        const int qi = 16 * w + i16;
        const int sbase = 128 + qi - 32 * T0 - 8 * g4; const unsigned smax = blk > 0 ? 128u : (unsigned)qi;
        float mx = -1e30f;
#pragma unroll
        for (int T = 0; T < 5; ++T)
#pragma unroll
            for (int u = 0; u < 2; ++u)
#pragma unroll
                for (int r = 0; r < 4; ++r) { const int steps = sbase - (32 * T + 4 * u + r);
                    const bool valid = (unsigned)steps <= smax;
                    const float l = valid ? S[T][u][r] * c1 - c2 * (float)steps : -1e30f; S[T][u][r] = l; mx = fmaxf(mx, l); }
        mx = fmaxf(mx, __shfl_xor(mx, 16)); mx = fmaxf(mx, __shfl_xor(mx, 32));
        float den = 0.f; bf16x8 pf[5];
#pragma unroll
        for (int T = 0; T < 5; ++T) { float p[8];
#pragma unroll
            for (int u = 0; u < 2; ++u)
#pragma unroll
                for (int r = 0; r < 4; ++r) { const float e = __builtin_amdgcn_exp2f(S[T][u][r] - mx); p[4 * u + r] = e; den += e; }
            v4u pw; pw.x = pg8::cvt_pk_bf16(p[0], p[1]); pw.y = pg8::cvt_pk_bf16(p[2], p[3]); pw.z = pg8::cvt_pk_bf16(p[4], p[5]); pw.w = pg8::cvt_pk_bf16(p[6], p[7]);
            pf[T] = __builtin_bit_cast(bf16x8, pw); }
        den += __shfl_xor(den, 16); den += __shfl_xor(den, 32);
        if (has_next) asm volatile("s_waitcnt vmcnt(12)" ::: "memory"); else asm volatile("s_waitcnt vmcnt(0)" ::: "memory");
        __builtin_amdgcn_s_barrier(); asm volatile("" ::: "memory");
        unsigned va0;
        { const unsigned q = (lane & 15) >> 2, p = lane & 3; va0 = off_b(32u * T0 + 8u * g4 + q, (p >> 1)) + 8u * (p & 1); }
        asm volatile("" : "+v"(va0));
        f32x4 O[8];
#pragma unroll
        for (int dt = 0; dt < 8; ++dt) { O[dt] = (f32x4){0.f, 0.f, 0.f, 0.f};
            const unsigned vd = va0 ^ (unsigned)(dt << 5);
#pragma unroll
            for (int T = 0; T < 5; ++T) {
                const s16x4 v0 = __builtin_amdgcn_ds_read_tr16_b64_v4i16((LAS s16x4*)(Vt + (vd + 8192u * T)));
                const s16x4 v1 = __builtin_amdgcn_ds_read_tr16_b64_v4i16((LAS s16x4*)(Vt + ((vd ^ 16u) + 1024u + 8192u * T)));
                const bf16x8 vf = (bf16x8){v0[0], v0[1], v0[2], v0[3], v1[0], v1[1], v1[2], v1[3]};
                O[dt] = __builtin_amdgcn_mfma_f32_16x16x32_bf16(vf, pf[T], O[dt], 0, 0, 0); } }
        asm volatile("" ::: "memory"); __builtin_amdgcn_s_barrier(); asm volatile("" ::: "memory");
        const float id = 1.0f / den;
        bf16* op = QB + qtok * QKVW + hh * HD + 4 * g4;
#pragma unroll
        for (int dt = 0; dt < 8; ++dt) { v2u o; o.x = pg8::cvt_pk_bf16(O[dt][0] * id, O[dt][1] * id); o.y = pg8::cvt_pk_bf16(O[dt][2] * id, O[dt][3] * id); *(v2u*)(op + 16 * dt) = o; }
        if (g4 == 0) LSE[qtok * 24 + hh] = (mx + __builtin_amdgcn_logf(den)) * 0.6931471805599453f;
        asm volatile("" ::: "memory");
        if (!has_next) break;
        attn_stage(VB, Vt, nu, w, lane);
        asm volatile("" ::: "memory");
        cu = nu; ++un;
    }
    asm volatile("s_waitcnt vmcnt(0)" ::: "memory");
    __syncthreads();
#undef ATTN_QLOAD
}

constexpr int N_PHASES = 12;
__global__ void __launch_bounds__(NWAVES * 64, 2) mk_fwd(Args args) {
    extern __shared__ __attribute__((aligned(16))) unsigned char lds[];
    Frame F;
    F.lds = (LAS unsigned char*)lds; F.MISC = (volatile LAS unsigned*)(F.lds + MISC_OFF);
    F.tid = threadIdx.x; F.lane = F.tid & 63; F.wave = __builtin_amdgcn_readfirstlane(F.tid >> 6);
    F.G = gridDim.x; F.gw = blockIdx.x * NWAVES + F.wave; F.NGW = F.G * NWAVES;
    F.ws = args.ws; F.out = args.out; F.ctl = (gu32*)(args.ws + WS_CTL);
    for (int u = F.tid; u < 32; u += NWAVES * 64) ((LAS unsigned*)(F.lds + MISC_OFF))[u] = 0u;
    __syncthreads();
    XcdBarrier bar; bar.bar = (unsigned*)(F.ctl + CW_BAR); bar.x = 0; bar.st = nullptr;
    if (MK_N_LAUNCHES == 1) bar = xcd_barrier_post((unsigned*)(F.ctl + CW_BAR), F.MISC + 8);
#define GRID_BAR() do { if (MK_N_LAUNCHES == 1) xcd_barrier(bar); } while (0)
    const int lo = args.ph_lo, hi = args.ph_hi;
#if defined(PROBE_A)
    volatile LAS unsigned long long* tst = (volatile LAS unsigned long long*)(F.lds + MISC_OFF + 128);
    if (threadIdx.x == 0) tst[0] = __builtin_amdgcn_s_memrealtime();
#define STAMP(k) do { if (threadIdx.x == 0) tst[(k) + 1] = __builtin_amdgcn_s_memrealtime(); } while (0)
#else
#define STAMP(k) do { } while (0)
#endif
#ifndef PHMASK
#define PHMASK 0xFFF
#endif
#define IN(k) (((PHMASK >> (k)) & 1) && lo <= (k) && (k) < hi)
#define BOTH(k) (IN(k) && IN((k) + 1))
    const int cid = (int)blockIdx.x;
#define PHASE_WS unsigned char* const ws = opaque_ptr(args.ws)
#define WSP(T, off) ((T*)(ws + (off)))
#define SS0 ((float*)(ws + WS_SS0))
#define SS1 ((float*)(ws + WS_CTL) + CW_SS1)
#define SS2 ((float*)(ws + WS_CTL) + CW_SS2)
#define SS3 ((float*)(ws + WS_CTL) + CW_SS3)
#define HOUT (args.out + O_Y)

    if (IN(0)) { p0_prologue(F, args); if (BOTH(0)) GRID_BAR(); }
    STAMP(0);
    if (IN(1)) { PHASE_WS; pg8::Gemm g{WSP(const bf16, WS_XB), WSP(const bf16, WS_W1T), M, 2 * FF, D, D, D, 0}; pg8::StaticOrder S; S.init(M, 2 * FF, F.G, cid);
        EpiSwiglu E{WSP(bf16, WS_HID), SS0}; pg8::gemm_phase<EpiSwiglu, pg8::StaticOrder>(F.lds + RING_OFF, g, S, E); if (BOTH(1)) GRID_BAR(); }
    STAMP(1);
    if (IN(2)) { PHASE_WS; pg8::Gemm g{WSP(const bf16, WS_HID), WSP(const bf16, WS_W2T), M, D, FF, FF, FF, 0}; pg8::StaticOrder S; S.init(M, D, F.G, cid);
        EpiResid E{args.in[I_XP], args.in[I_XS], HOUT, WSP(bf16, WS_XB), SS1, 0.5f}; pg8::gemm_phase<EpiResid, pg8::StaticOrder>(F.lds + RING_OFF, g, S, E); if (BOTH(2)) GRID_BAR(); }
    STAMP(2);
    if (IN(3)) { PHASE_WS; pg8::Gemm g{WSP(const bf16, WS_XB), WSP(const bf16, WS_WINT), M, INW, D, D, D, 0}; pg8::StaticOrder S; S.init(M, INW, F.G, cid);
        EpiWin E{ws, SS1, args.in[I_QN], args.in[I_KN], args.out, (LAS float*)(F.lds + XCH_OFF)};
        pg8::gemm_phase<EpiWin, pg8::StaticOrder>(F.lds + RING_OFF, g, S, E); if (BOTH(3)) GRID_BAR(); }
    STAMP(3);
    if (IN(4)) { PHASE_WS; pooling_phase(F, args); sample_attn_phase(F, args); attn_phase(F); if (BOTH(4)) GRID_BAR(); }
    STAMP(4);
    if (IN(5)) { PHASE_WS; pg8::Gemm g{WSP(const bf16, WS_POOLED), WSP(const bf16, WS_PMT), M, PW, 256, PW, 256, 256}; pg8::StaticOrder S; S.init(M, PW, F.G, cid);
        EpiScaleCol E{WSP(bf16, WS_YPOOL), PW, args.in[I_PSCALE]}; pg8::gemm_phase<EpiScaleCol, pg8::StaticOrder>(F.lds + RING_OFF, g, S, E);
        merge_phase(F); if (BOTH(5)) GRID_BAR(); }
    STAMP(5);
    if (IN(6)) { PHASE_WS; pg8::Gemm g{WSP(const bf16, WS_YPOOL), WSP(const bf16, WS_WPOT), M, D, PW, PW, PW, 0}; pg8::StaticOrder S; S.init(M, D, F.G, cid);
        EpiGate<false> E{WSP(bf16, WS_MB), WSP(const bf16, WS_GB), 0}; pg8::gemm_phase<EpiGate<false>, pg8::StaticOrder>(F.lds + RING_OFF, g, S, E); if (BOTH(6)) GRID_BAR(); }
    STAMP(6);
    if (IN(7)) { PHASE_WS; pg8::Gemm g{WSP(const bf16, WS_OATT), WSP(const bf16, WS_WAOT), M, D, PW, PW, PW, 0}; pg8::StaticOrder S; S.init(M, D, F.G, cid);
        EpiGate<true> E{WSP(bf16, WS_MB), WSP(const bf16, WS_GB), 2048}; pg8::gemm_phase<EpiGate<true>, pg8::StaticOrder>(F.lds + RING_OFF, g, S, E); if (BOTH(7)) GRID_BAR(); }
    STAMP(7);
    if (IN(8)) { PHASE_WS; { pg8::Gemm g{WSP(const bf16, WS_MB), WSP(const bf16, WS_WOT), M, D, D, D, D, 0}; pg8::StaticOrder S; S.init(M, D, F.G, cid);
          EpiResid E{HOUT, HOUT + (size_t)MP * D, HOUT, WSP(bf16, WS_XB), SS2, 1.0f}; pg8::gemm_phase<EpiResid, pg8::StaticOrder>(F.lds + RING_OFF, g, S, E); }
        { pg8::Gemm g{WSP(const bf16, WS_PB), WSP(const bf16, WS_PPT), M, D, DPLE, DPLE, DPLE, 0}; pg8::StaticOrder S; S.init(M, D, F.G, cid);
          EpiScaleCol E{WSP(bf16, WS_PP), D, nullptr}; pg8::gemm_phase<EpiScaleCol, pg8::StaticOrder>(F.lds + RING_OFF, g, S, E); }
        if (BOTH(8)) GRID_BAR(); }
    STAMP(8);
    if (IN(9)) { PHASE_WS; pg8::Gemm g{WSP(const bf16, WS_XB), WSP(const bf16, WS_W3T), M, 2 * FF, D, D, D, 0}; pg8::StaticOrder S; S.init(M, 2 * FF, F.G, cid);
        EpiSwiglu E{WSP(bf16, WS_HID), SS2}; pg8::gemm_phase<EpiSwiglu, pg8::StaticOrder>(F.lds + RING_OFF, g, S, E); if (BOTH(9)) GRID_BAR(); }
    STAMP(9);
    if (IN(10)) { PHASE_WS; pg8::Gemm g{WSP(const bf16, WS_HID), WSP(const bf16, WS_W4T), M, D, FF, FF, FF, 0}; pg8::StaticOrder S; S.init(M, D, F.G, cid);
        EpiResid E{HOUT, HOUT + (size_t)MP * D, HOUT, WSP(bf16, WS_XB), SS3, 0.5f}; pg8::gemm_phase<EpiResid, pg8::StaticOrder>(F.lds + RING_OFF, g, S, E); if (BOTH(10)) GRID_BAR(); }
    STAMP(10);
    if (IN(11)) { PHASE_WS; pg8::Gemm g{WSP(const bf16, WS_XB), WSP(const bf16, WS_PGT), M, D, D, D, D, 0}; pg8::StaticOrder S; S.init(M, D, F.G, cid);
        EpiFinal E{HOUT, WSP(const bf16, WS_PP), SS3}; pg8::gemm_phase<EpiFinal, pg8::StaticOrder>(F.lds + RING_OFF, g, S, E); }
    STAMP(11);
#if defined(PROBE_A)
    if (blockIdx.x == 0 && threadIdx.x == 0) {
        unsigned long long da = tst[PROBE_A + 1] - tst[PROBE_A], db = tst[PROBE_B + 1] - tst[PROBE_B];
        unsigned na = (unsigned)(da / 2500ull), nb = (unsigned)(db / 2500ull); na = na > 63u ? 63u : na; nb = nb > 63u ? 63u : nb;
        const unsigned long long extra = (unsigned long long)(na * 64u + nb) * 10000ull, t0 = __builtin_amdgcn_s_memrealtime();
        while (__builtin_amdgcn_s_memrealtime() - t0 < extra) __builtin_amdgcn_s_sleep(32);
    }
#endif
#undef IN
#undef BOTH
}

extern "C" void kernel_launch(void* const* d_in, const int* in_sizes, int n_in, void* d_out, int out_size, void* d_ws, size_t ws_size, hipStream_t stream) {
    static int grid = 0;
    if (grid == 0) {
        if (n_in != 29 || (size_t)out_size != O_END || ws_size < WS_END) { fprintf(stderr, "kernel_launch: unexpected sizes: n_in %d out %d ws %zu (need %zu)\n", n_in, out_size, ws_size, (size_t)WS_END); grid = -1; return; }
        int dev = 0, cus = 0;
        if (hipGetDevice(&dev) != hipSuccess || hipDeviceGetAttribute(&cus, hipDeviceAttributeMultiprocessorCount, dev) != hipSuccess) { grid = -1; return; }
        if (hipFuncSetAttribute((const void*)mk_fwd, hipFuncAttributeMaxDynamicSharedMemorySize, LDS_BYTES) != hipSuccess) { grid = -1; return; }
        int per_cu = 0;
        (void)hipOccupancyMaxActiveBlocksPerMultiprocessor(&per_cu, (const void*)mk_fwd, NWAVES * 64, LDS_BYTES);
        (void)hipGetLastError();
        grid = cus;
    }
    if (grid < 0) return;
    (void)hipMemsetAsync((char*)d_ws + WS_CTL, 0, CTL_ZERO_BYTES, stream);
    Args a{};
    for (int i = 0; i < 29; ++i) a.in[i] = (const float*)d_in[i];
    a.out = (float*)d_out; a.ws = (unsigned char*)d_ws;
    if (MK_N_LAUNCHES == 1) { a.ph_lo = 0; a.ph_hi = N_PHASES; a.li = 0; hipLaunchKernelGGL(mk_fwd, dim3(grid), dim3(NWAVES * 64), LDS_BYTES, stream, a); }
    else for (int li = 0; li < N_PHASES; ++li) { a.ph_lo = li; a.ph_hi = li + 1; a.li = li; hipLaunchKernelGGL(mk_fwd, dim3(grid), dim3(NWAVES * 64), LDS_BYTES, stream, a); }
}
```

```cpp
#include <hip/hip_runtime.h>
#include <cstdio>
#include <cstdint>

#ifndef MK_N_LAUNCHES
#define MK_N_LAUNCHES 1
#endif

namespace pg8 {
#define PG8_LAS __attribute__((address_space(3)))
typedef unsigned short bf16_t;
typedef short bf16x8 __attribute__((ext_vector_type(8)));
typedef float f32x4 __attribute__((ext_vector_type(4)));
typedef unsigned u32x4 __attribute__((ext_vector_type(4)));
typedef unsigned u32x2 __attribute__((ext_vector_type(2)));
constexpr int BM = 256, BK = 64, HALF = 128, HTB = HALF * BK * 2, STAGE_BYTES = 8 * HTB, NXCD = 8, WGM = 8;

__host__ __device__ __forceinline__ int lds_byte(int r, int c) { const int st = (r >> 4) * 2 + (c >> 5), rr = r & 15, cc = c & 31, ob = rr * 64 + cc * 2; return st * 1024 + (ob ^ (((ob >> 9) & 1) << 5)); }
__host__ __device__ __forceinline__ void stage_rc(int b, int& R, int& C) { const int st = b / 1024, sb = b % 1024, swz = sb ^ (((sb >> 9) & 1) << 5); R = (st >> 1) * 16 + swz / 64; C = (st & 1) * 32 + (swz % 64) / 2; }
__host__ __device__ __forceinline__ int perm32(int rho) { const int n = rho >> 4, i = rho & 15; return 8 * (i >> 2) + 4 * n + (i & 3); }

struct Unit { int pm, pn, lin; };
struct Gemm { const bf16_t* A; const bf16_t* Bt; int M, N, K, lda, ldb, a_pn_off; };

struct StaticOrder {
    int nM, nN, nwg, G, c, wgm;
    __host__ __device__ void init(int M, int N, int G_, int c_, int wgm_ = WGM) { nM = M / BM; nN = N / BM; nwg = nM * nN; G = G_; c = c_; wgm = wgm_; }
    __host__ __device__ bool next(int i, Unit& u) const {
        const long L = (long)i * G + c; if (L >= nwg) return false;
        int wgid = (int)L; { const int q = nwg / NXCD, r = nwg % NXCD, xcd = wgid % NXCD, off = wgid / NXCD; wgid = (xcd < r ? xcd * (q + 1) : r * (q + 1) + (xcd - r) * q) + off; }
        const int nig = wgm * nN, gid = wgid / nig, fm = gid * wgm, gsz = (nM - fm) < wgm ? (nM - fm) : wgm;
        u.pm = fm + ((wgid % nig) % gsz); u.pn = (wgid % nig) / gsz; u.lin = (int)L; return true;
    }
    __device__ __forceinline__ void a_ready(const Unit&) const {}
    __device__ __forceinline__ void done(const Unit&) const {}
};

__device__ __forceinline__ unsigned cvt_pk_bf16(float lo, float hi) { unsigned r; asm volatile("v_cvt_pk_bf16_f32 %0, %1, %2" : "=v"(r) : "v"(lo), "v"(hi)); return r; }
__device__ __forceinline__ float bf_lo(unsigned w) { return __uint_as_float(w << 16); }
__device__ __forceinline__ float bf_hi(unsigned w) { return __uint_as_float(w & 0xffff0000u); }
__device__ __forceinline__ u32x4 pack8(const f32x4& v0, const f32x4& v1) { u32x4 w; w.x = cvt_pk_bf16(v0[0], v0[1]); w.y = cvt_pk_bf16(v0[2], v0[3]); w.z = cvt_pk_bf16(v1[0], v1[1]); w.w = cvt_pk_bf16(v1[2], v1[3]); return w; }
__device__ __forceinline__ void unpack8(const u32x4& w, f32x4& v0, f32x4& v1) { v0 = (f32x4){bf_lo(w.x), bf_hi(w.x), bf_lo(w.y), bf_hi(w.y)}; v1 = (f32x4){bf_lo(w.z), bf_hi(w.z), bf_lo(w.w), bf_hi(w.w)}; }
__device__ __forceinline__ float sigmoidf_(float x) { return __builtin_amdgcn_rcpf(1.0f + __builtin_amdgcn_exp2f(-1.4426950408889634f * x)); }

template <class Epi, class Sched, bool ALIGN_EPI = true, bool SP2 = true>
__device__ __forceinline__ void gemm_phase(PG8_LAS unsigned char* lds, const Gemm g, const Sched& S, const Epi& E) {
    int tid_ = threadIdx.x; asm volatile("" : "+v"(tid_));
    const int tid = tid_, wid = __builtin_amdgcn_readfirstlane(tid >> 6), lane = tid & 63, wr = wid >> 2, wc = wid & 3, fr = lane & 15, fq = lane >> 4;
    int K_ = g.K; asm volatile("" : "+s"(K_));
    const int K = K_, nt = K / BK;
    unsigned voffA[2], voffB[2];
#pragma unroll
    for (int i = 0; i < 2; ++i) { int R, C; stage_rc(tid * 16 + i * 8192, R, C); const int Rb = Epi::PERM ? ((R & ~31) + perm32(R & 31)) : R;
        voffA[i] = (unsigned)(R * g.lda + C) * 2u; voffB[i] = (unsigned)(Rb * g.ldb + C) * 2u; }
    const unsigned kstep = (unsigned)(BK * 2);
    const unsigned hstepA = (unsigned)HALF * g.lda * 2, hstepB = (unsigned)HALF * g.ldb * 2;
    const unsigned tstepA = 2 * hstepA, tstepB = 2 * hstepB;
    const unsigned ldsw = (unsigned)wid * 1024u;
    const int aoff = lds_byte(wr * 64 + fr, fq * 8), boff = lds_byte(wc * 32 + fr, fq * 8);
#define PG8_SA(b, h) (((b) * 2 + (h)) * HTB)
#define PG8_SB(b, h) ((4 + (b) * 2 + (h)) * HTB)
#define PG8_STAGE(bufoff, gbase, voff) do { _Pragma("unroll") for (int _i = 0; _i < 2; ++_i) \
        __builtin_amdgcn_global_load_lds((const unsigned*)((const char*)(gbase) + (voff)[_i]), (PG8_LAS unsigned*)(lds + (bufoff) + ldsw + _i * 8192), 16, 0, 0); } while (0)
#define PG8_LDA(dst, b, h) do { _Pragma("unroll") for (int m = 0; m < 4; ++m) _Pragma("unroll") for (int k = 0; k < 2; ++k) dst[m][k] = *(const PG8_LAS bf16x8*)(lds + PG8_SA(b, h) + aoff + m * 2048 + k * 1024); } while (0)
#define PG8_LDB(dst, b, h) do { _Pragma("unroll") for (int n = 0; n < 2; ++n) _Pragma("unroll") for (int k = 0; k < 2; ++k) dst[n][k] = *(const PG8_LAS bf16x8*)(lds + PG8_SB(b, h) + boff + n * 2048 + k * 1024); } while (0)
#define PG8_MMA(ai, bj, At, Bt) do { __builtin_amdgcn_s_setprio(1); _Pragma("unroll") for (int m = 0; m < 4; ++m) _Pragma("unroll") for (int n = 0; n < 2; ++n) _Pragma("unroll") for (int k = 0; k < 2; ++k) \
        acc[ai][bj][m][n] = __builtin_amdgcn_mfma_f32_16x16x32_bf16(Bt[n][k], At[m][k], acc[ai][bj][m][n], 0, 0, 0); __builtin_amdgcn_s_setprio(0); } while (0)
#define PG8_WAIT_V(n) asm volatile("s_waitcnt vmcnt(" #n ")" ::: "memory")
#define PG8_WAIT_L(n) asm volatile("s_waitcnt lgkmcnt(" #n ")" ::: "memory")
#define PG8_BAR __builtin_amdgcn_s_barrier()
#define PG8_SCHED __builtin_amdgcn_sched_barrier(0)
    Unit cur, nxt; int ui = 0;
    if (!S.next(0, cur)) return;
    f32x4 acc[2][2][4][2];
#pragma unroll
    for (int a = 0; a < 2; ++a)
#pragma unroll
        for (int b = 0; b < 2; ++b)
#pragma unroll
            for (int m = 0; m < 4; ++m)
#pragma unroll
                for (int n = 0; n < 2; ++n) acc[a][b][m][n] = (f32x4){0.f, 0.f, 0.f, 0.f};
    bf16x8 At[4][2], B0[2][2], B1[2][2];
    const char* cA = (const char*)g.A + (size_t)cur.pm * tstepA + (size_t)cur.pn * g.a_pn_off * 2; const char* cB = (const char*)g.Bt + (size_t)cur.pn * tstepB;
    S.a_ready(cur);
    if constexpr (SP2) {
        PG8_STAGE(PG8_SB(0, 0), cB, voffB); PG8_STAGE(PG8_SB(0, 1), cB + hstepB, voffB); PG8_STAGE(PG8_SA(0, 0), cA, voffA); PG8_STAGE(PG8_SA(0, 1), cA + hstepA, voffA);
        if (wr == 1) PG8_BAR;
        PG8_WAIT_V(2); PG8_BAR;
        PG8_STAGE(PG8_SB(1, 0), cB + kstep, voffB); PG8_STAGE(PG8_SA(1, 0), cA + kstep, voffA); PG8_STAGE(PG8_SB(1, 1), cB + hstepB + kstep, voffB);
        PG8_WAIT_V(6); PG8_BAR;
    } else {
        PG8_STAGE(PG8_SB(0, 0), cB, voffB); PG8_STAGE(PG8_SA(0, 0), cA, voffA); PG8_STAGE(PG8_SB(0, 1), cB + hstepB, voffB); PG8_STAGE(PG8_SA(0, 1), cA + hstepA, voffA);
        if (wr == 1) PG8_BAR;
        PG8_WAIT_V(4); PG8_BAR;
        PG8_STAGE(PG8_SB(1, 0), cB + kstep, voffB); PG8_STAGE(PG8_SA(1, 0), cA + kstep, voffA); PG8_STAGE(PG8_SB(1, 1), cB + hstepB + kstep, voffB);
        PG8_WAIT_V(6); PG8_BAR;
    }
    for (;;) {
        const bool has_next = S.next(ui + 1, nxt);
        const char* nA = has_next ? (const char*)g.A + (size_t)nxt.pm * tstepA + (size_t)nxt.pn * g.a_pn_off * 2 : cA; const char* nB = has_next ? (const char*)g.Bt + (size_t)nxt.pn * tstepB : cB;
        for (int t = 0; t < nt; t += 2) {
            const bool last = (t == nt - 2);
            const char* a1 = cA + (size_t)(t + 1) * kstep;
            const char* a2 = last ? nA : cA + (size_t)(t + 2) * kstep; const char* b2 = last ? nB : cB + (size_t)(t + 2) * kstep;
            const char* a3 = a2 + kstep; const char* b3 = b2 + kstep;
            if (last && has_next) S.a_ready(nxt);
            if constexpr (SP2) {
            PG8_LDB(B0, 0, 0); PG8_LDB(B1, 0, 1); PG8_SCHED; PG8_LDA(At, 0, 0); PG8_STAGE(PG8_SA(1, 1), a1 + hstepA, voffA);
            PG8_WAIT_V(8); PG8_WAIT_L(0); PG8_BAR; PG8_MMA(0, 0, At, B0); PG8_MMA(0, 1, At, B1); PG8_BAR; PG8_SCHED;
            PG8_LDA(At, 0, 1); PG8_STAGE(PG8_SB(0, 0), b2, voffB); PG8_STAGE(PG8_SB(0, 1), b2 + hstepB, voffB); PG8_STAGE(PG8_SA(0, 0), a2, voffA);
            PG8_WAIT_V(8); PG8_WAIT_L(0); PG8_BAR; PG8_MMA(1, 0, At, B0); PG8_MMA(1, 1, At, B1); PG8_BAR; PG8_SCHED;
            PG8_LDB(B0, 1, 0); PG8_LDB(B1, 1, 1); PG8_SCHED; PG8_LDA(At, 1, 0); PG8_STAGE(PG8_SA(0, 1), a2 + hstepA, voffA);
            PG8_WAIT_V(8); PG8_WAIT_L(0); PG8_BAR; PG8_MMA(0, 0, At, B0); PG8_MMA(0, 1, At, B1); PG8_BAR; PG8_SCHED;
            PG8_LDA(At, 1, 1); PG8_STAGE(PG8_SB(1, 0), b3, voffB); PG8_STAGE(PG8_SB(1, 1), b3 + hstepB, voffB); PG8_STAGE(PG8_SA(1, 0), a3, voffA);
            PG8_WAIT_V(8); PG8_WAIT_L(0); PG8_BAR; PG8_MMA(1, 0, At, B0); PG8_MMA(1, 1, At, B1); PG8_BAR; PG8_SCHED;
            } else {
            PG8_LDB(B0, 0, 0); PG8_SCHED; PG8_LDA(At, 0, 0); PG8_STAGE(PG8_SA(1, 1), a1 + hstepA, voffA);
            PG8_WAIT_L(8); PG8_BAR; PG8_WAIT_L(0); PG8_MMA(0, 0, At, B0); PG8_BAR; PG8_SCHED;
            PG8_LDB(B1, 0, 1); PG8_STAGE(PG8_SB(0, 0), b2, voffB);
            PG8_BAR; PG8_WAIT_L(0); PG8_MMA(0, 1, At, B1); PG8_BAR;
            PG8_LDA(At, 0, 1); PG8_STAGE(PG8_SA(0, 0), a2, voffA);
            PG8_BAR; PG8_WAIT_L(0); PG8_MMA(1, 0, At, B0); PG8_BAR; PG8_SCHED;
            PG8_STAGE(PG8_SB(0, 1), b2 + hstepB, voffB);
            PG8_WAIT_V(6); PG8_BAR; PG8_MMA(1, 1, At, B1); PG8_BAR;
            PG8_LDB(B0, 1, 0); PG8_SCHED; PG8_LDA(At, 1, 0); PG8_STAGE(PG8_SA(0, 1), a2 + hstepA, voffA);
            PG8_WAIT_L(8); PG8_BAR; PG8_WAIT_L(0); PG8_MMA(0, 0, At, B0); PG8_BAR; PG8_SCHED;
            PG8_LDB(B1, 1, 1); PG8_STAGE(PG8_SB(1, 0), b3, voffB);
            PG8_BAR; PG8_WAIT_L(0); PG8_MMA(0, 1, At, B1); PG8_BAR;
            PG8_LDA(At, 1, 1); PG8_STAGE(PG8_SA(1, 0), a3, voffA);
            PG8_BAR; PG8_WAIT_L(0); PG8_MMA(1, 0, At, B0); PG8_BAR; PG8_SCHED;
            PG8_STAGE(PG8_SB(1, 1), b3 + hstepB, voffB);
            PG8_WAIT_V(6); PG8_BAR; PG8_MMA(1, 1, At, B1); PG8_BAR;
            }
        }
        if constexpr (ALIGN_EPI) { if (wr == 0) PG8_BAR; }
        E(acc, cur, wr, wc, fr, fq);
        if (!has_next) break;
#pragma unroll
        for (int a = 0; a < 2; ++a)
#pragma unroll
            for (int b = 0; b < 2; ++b)
#pragma unroll
                for (int m = 0; m < 4; ++m)
#pragma unroll
                    for (int n = 0; n < 2; ++n) acc[a][b][m][n] = (f32x4){0.f, 0.f, 0.f, 0.f};
        cur = nxt; cA = nA; cB = nB; ++ui;
        if constexpr (ALIGN_EPI) { if (wr == 1) PG8_BAR; }
    }
    PG8_WAIT_V(0);
    if constexpr (!ALIGN_EPI) { if (wr == 0) PG8_BAR; }
    PG8_BAR;
#undef PG8_SA
#undef PG8_SB
#undef PG8_STAGE
#undef PG8_LDA
#undef PG8_LDB
#undef PG8_MMA
#undef PG8_WAIT_V
#undef PG8_WAIT_L
#undef PG8_BAR
#undef PG8_SCHED
}
}

constexpr int NWAVES = 8;
constexpr int D = 2048, FF = 5632, PW = 1024, QKVW = 3072, INW = 14336, DPLE = 256, HD = 128;
constexpr int NB_P = 16, T_P = 2048, NB_S = 32, T_S = 8;
constexpr int MP = NB_P * T_P, MS = NB_S * T_S, M = MP + MS;
constexpr float RMS_EPS = 1e-6f;
static_assert(M % 256 == 0, "M");

constexpr size_t O_Y = 0;
constexpr size_t O_SPP = (size_t)M * D;
constexpr size_t O_K0P = O_SPP + (size_t)16 * 15 * 1024;
constexpr size_t O_V0P = O_K0P + (size_t)16 * 128 * 1024;
constexpr size_t O_K1P = O_V0P + (size_t)16 * 128 * 1024;
constexpr size_t O_V1P = O_K1P + (size_t)16 * 512 * 1024;
constexpr size_t O_K2P = O_V1P + (size_t)16 * 512 * 1024;
constexpr size_t O_V2P = O_K2P + (size_t)16 * 2048 * 1024;
constexpr size_t O_SPS = O_V2P + (size_t)16 * 2048 * 1024;
constexpr size_t O_K0S = O_SPS + (size_t)32 * 15 * 1024;
constexpr size_t O_V0S = O_K0S + (size_t)32 * 128 * 1024;
constexpr size_t O_K1S = O_V0S + (size_t)32 * 128 * 1024;
constexpr size_t O_V1S = O_K1S + (size_t)32 * 512 * 1024;
constexpr size_t O_K2S = O_V1S + (size_t)32 * 512 * 1024;
constexpr size_t O_V2S = O_K2S + (size_t)32 * 2048 * 1024;
constexpr size_t O_END = O_V2S + (size_t)32 * 2048 * 1024;
static_assert(O_END == 332611584ull, "d_out size");

constexpr size_t MiB = 1u << 20;
constexpr size_t WS_CTL = 0, CTL_ZERO_BYTES = 1 * MiB;
constexpr size_t WS_SS0 = 1 * MiB;
constexpr size_t WS_LSE = 2 * MiB;
constexpr size_t WS_W1T = 8 * MiB;
constexpr size_t WS_W2T = WS_W1T + 44 * MiB;
constexpr size_t WS_WINT = WS_W2T + 22 * MiB;
constexpr size_t WS_PMT = WS_WINT + 56 * MiB;
constexpr size_t WS_WPOT = WS_PMT + 1 * MiB;
constexpr size_t WS_WAOT = WS_WPOT + 4 * MiB;
constexpr size_t WS_WOT = WS_WAOT + 4 * MiB;
constexpr size_t WS_W3T = WS_WOT + 8 * MiB;
constexpr size_t WS_W4T = WS_W3T + 44 * MiB;
constexpr size_t WS_PGT = WS_W4T + 22 * MiB;
constexpr size_t WS_PPT = WS_PGT + 8 * MiB;
constexpr size_t WS_PB = WS_PPT + 1 * MiB;
constexpr size_t WS_XB = WS_PB + 17 * MiB;
constexpr size_t WS_ZB = WS_XB + 129 * MiB;
constexpr size_t WS_QB = WS_ZB + 65 * MiB;
constexpr size_t WS_KB = WS_QB + 194 * MiB;
constexpr size_t WS_VB = WS_KB + 194 * MiB;
constexpr size_t WS_GB = WS_VB + 194 * MiB;
constexpr size_t WS_END = WS_GB + 258 * MiB;
constexpr size_t WS_HID = WS_QB;
constexpr size_t DO_POOLED = 0, DO_YPOOL = (size_t)M * PW * 2;
static_assert(DO_YPOOL + (size_t)M * PW * 2 <= (size_t)M * D * 4, "POOLED/YPOOL inside the y region");
constexpr size_t WS_OATT = WS_ZB;
constexpr size_t WS_MB = WS_VB;
constexpr size_t WS_PP = WS_GB;
static_assert(WS_HID + (size_t)M * FF * 2 <= WS_VB, "HID overlay");
static_assert(WS_SS0 + (size_t)M * 4 <= WS_LSE && WS_LSE + (size_t)M * 24 * 4 <= WS_W1T, "small buffers");
static_assert(WS_W1T + (size_t)2 * FF * D * 2 <= WS_W2T && WS_W2T + (size_t)D * FF * 2 <= WS_WINT && WS_WINT + (size_t)INW * D * 2 <= WS_PMT && WS_PMT + (size_t)PW * 256 * 2 <= WS_WPOT, "weights 1");
static_assert(WS_WPOT + (size_t)D * PW * 2 <= WS_WAOT && WS_WAOT + (size_t)D * PW * 2 <= WS_WOT && WS_WOT + (size_t)D * D * 2 <= WS_W3T && WS_W3T + (size_t)2 * FF * D * 2 <= WS_W4T, "weights 2");
static_assert(WS_W4T + (size_t)D * FF * 2 <= WS_PGT && WS_PGT + (size_t)D * D * 2 <= WS_PPT && WS_PPT + (size_t)D * DPLE * 2 <= WS_PB && WS_PB + (size_t)M * DPLE * 2 <= WS_XB, "weights 3");
static_assert(WS_XB + (size_t)M * D * 2 <= WS_ZB && WS_ZB + (size_t)M * PW * 2 <= WS_QB && WS_QB + (size_t)M * QKVW * 2 <= WS_KB && WS_KB + (size_t)M * QKVW * 2 <= WS_VB, "activations 1");
static_assert(WS_VB + (size_t)M * QKVW * 2 <= WS_GB && WS_GB + (size_t)M * 4096 * 2 <= WS_END, "activations 2");
static_assert(WS_MB + (size_t)M * D * 2 <= WS_GB && WS_PP + (size_t)M * D * 2 <= WS_END && WS_OATT + (size_t)M * PW * 2 <= WS_QB, "overlays");
static_assert(WS_END <= 1390ull * MiB, "workspace budget");
constexpr int CW_TMO = 0, CW_CODE = 1, CW_BAR = 4096;
constexpr int CW_SS1 = 16384, CW_SS2 = CW_SS1 + 33280, CW_SS3 = CW_SS2 + 33280;
static_assert((CW_SS3 + 33280) * 4 <= (int)CTL_ZERO_BYTES, "CTL");

constexpr int RING_OFF = 0, RING_BYTES = 131072;
constexpr int XCH_OFF = RING_BYTES;
constexpr int MISC_OFF = XCH_OFF + 8192;
constexpr int LDS_BYTES = 147456;
static_assert(MISC_OFF + 128 + 128 <= LDS_BYTES, "LDS map");

#define GAS __attribute__((address_space(1)))
#define LAS __attribute__((address_space(3)))
typedef unsigned short bf16;
typedef unsigned v4u __attribute__((ext_vector_type(4)));
typedef unsigned v2u __attribute__((ext_vector_type(2)));
typedef float f32x4 __attribute__((ext_vector_type(4)));
typedef float f32x2 __attribute__((ext_vector_type(2)));
typedef short bf16x8 __attribute__((ext_vector_type(8)));
typedef short s16x4 __attribute__((ext_vector_type(4)));
typedef GAS unsigned gu32;
#define RLX_AGENT __ATOMIC_RELAXED, __HIP_MEMORY_SCOPE_AGENT
#define LDS_WAIT() asm volatile("s_waitcnt lgkmcnt(0)" ::: "memory")
#define VM_WAIT() asm volatile("s_waitcnt vmcnt(0)" ::: "memory")
__device__ __forceinline__ unsigned f2bf(float f) { unsigned u = __builtin_bit_cast(unsigned, f); return (u + 0x7fffu + ((u >> 16) & 1u)) >> 16; }
__device__ __forceinline__ unsigned pk2(float lo, float hi) { return f2bf(lo) | (f2bf(hi) << 16); }
__device__ __forceinline__ float bf2f(unsigned short b) { return __uint_as_float(((unsigned)b) << 16); }

#define XB_TMO      128
#define XB_XCNT(j)  (256  + 64 * (j))
#define XB_XSUB(j)  (1280 + 64 * (j))
#define XB_XGEN(j)  (2304 + 64 * (j))
#define XB_TOP      3328
#define XB_TOPGEN   3392
#define XCD_BAR_WORDS 3456
#define XB_SPIN_CAP (1u << 20)

__device__ __forceinline__ unsigned xb_ld(unsigned* p)              { return __hip_atomic_load(p, __ATOMIC_RELAXED, __HIP_MEMORY_SCOPE_AGENT); }
__device__ __forceinline__ unsigned xb_add(unsigned* p, unsigned v) { return __hip_atomic_fetch_add(p, v, __ATOMIC_RELAXED, __HIP_MEMORY_SCOPE_AGENT); }
__device__ __forceinline__ unsigned xb_xcc_id() { return (unsigned)__builtin_amdgcn_s_getreg((3 << 11) | 20) & 0xFu; }
#define XB_SPIN(cond, bar) do { unsigned _sp = 0; while (cond) { __builtin_amdgcn_s_sleep(1); \
    if ((++_sp & 255u) == 0u) { if (xb_ld(&(bar)[XB_TMO])) break; if (_sp > XB_SPIN_CAP) { atomicAdd(&(bar)[XB_TMO], 1u); break; } } } } while (0)

struct XcdBarrier { unsigned* bar; unsigned x; volatile LAS unsigned* st; };

__device__ __forceinline__ XcdBarrier xcd_barrier_post(unsigned* bar, volatile LAS unsigned* st) {
    XcdBarrier b; b.bar = bar; b.x = xb_xcc_id(); b.st = st;
    if (threadIdx.x == 0) (void)xb_add(&bar[XB_XCNT(b.x)], 1u);
    return b;
}
__device__ __forceinline__ void xcd_barrier_complete(unsigned* bar, unsigned x, unsigned& nloc, unsigned& nx) {
    const unsigned G = gridDim.x * gridDim.y * gridDim.z;
    unsigned sum, cnt, mine, sp = 0u;
    for (;;) {
        sum = 0u; cnt = 0u; mine = 0u;
#pragma unroll
        for (unsigned j = 0; j < 16; ++j) { const unsigned c = xb_ld(&bar[XB_XCNT(j)]); sum += c; cnt += (c > 0u) ? 1u : 0u; mine = (j == x) ? c : mine; }
        if (sum == G) break;
        __builtin_amdgcn_s_sleep(1);
        if ((++sp & 255u) == 0u) { if (xb_ld(&bar[XB_TMO])) break; if (sp > XB_SPIN_CAP) { atomicAdd(&bar[XB_TMO], 1u); break; } }
    }
    nloc = mine > 0u ? mine : 1u; nx = cnt > 0u ? cnt : 1u;
}
__device__ __forceinline__ void xcd_barrier(const XcdBarrier& b) {
    asm volatile("s_waitcnt vmcnt(0)" ::: "memory");
    __syncthreads();
    if (threadIdx.x == 0) {
        unsigned* bar = b.bar;
        __builtin_amdgcn_s_waitcnt(0);
        unsigned nloc = b.st[0], nx = b.st[1];
        if (nloc == 0u) { xcd_barrier_complete(bar, b.x, nloc, nx); b.st[0] = nloc; b.st[1] = nx; }
        const unsigned old = xb_add(&bar[XB_XSUB(b.x)], 1u);
        const unsigned gen = old / nloc;
        if (old + 1u == (gen + 1u) * nloc) {
            __builtin_amdgcn_fence(__ATOMIC_RELEASE, "agent");
            asm volatile("s_waitcnt vmcnt(0)" ::: "memory");
            const unsigned og = xb_add(&bar[XB_TOP], 1u);
            const unsigned tg = og / nx;
            if (og + 1u == (tg + 1u) * nx) xb_add(&bar[XB_TOPGEN], 1u);
            else XB_SPIN(xb_ld(&bar[XB_TOPGEN]) == tg, bar);
            __builtin_amdgcn_fence(__ATOMIC_ACQUIRE, "agent");
            xb_add(&bar[XB_XGEN(b.x)], 1u);
            asm volatile("s_waitcnt vmcnt(0)" ::: "memory");
        } else {
            XB_SPIN(xb_ld(&bar[XB_XGEN(b.x)]) == gen, bar);
            __builtin_amdgcn_fence(__ATOMIC_ACQUIRE, "agent");
            asm volatile("s_waitcnt vmcnt(0)" ::: "memory");
        }
    }
    __syncthreads();
}

using pg8::f32x4; using pg8::u32x4; using pg8::Unit; using pg8::pack8; using pg8::unpack8; using pg8::sigmoidf_;
typedef const f32x4 (&AccT)[2][2][4][2];

constexpr int CP_CHUNK = 6144, CP_PER_PAIR = 85, CP_UNITS = 2 * NB_S * CP_PER_PAIR;
static_assert(CP_CHUNK * CP_PER_PAIR == (2048 - 8) * 256 && CP_UNITS <= (MP / 256) * (2 * FF / 256), "side-copy geometry");
static_assert(21 * CP_CHUNK == (512 - 8) * 256, "side-copy geometry 2");
struct EpiSwiglu {
    static constexpr bool PERM = true;
    bf16* O; const float* ss; const GAS float* csrc0; const GAS float* csrc1; GAS float* cdst0; GAS float* cdst1;
    int cper, cL;
    __device__ __forceinline__ void operator()(AccT acc, const Unit& u, int wr, int wc, int fr, int fq) const {
        bf16* Ou = O + (size_t)u.pm * 256 * FF + u.pn * 128; const float* ssu = ss + u.pm * 256;
        unsigned rl0 = wr * 64 + fr, c0 = wc * 32 + 8 * fq; asm volatile("" : "+v"(rl0), "+v"(c0));
        const bool cp = csrc0 != nullptr && u.lin < 2 * NB_S * cper;
        f32x4 cv[12]; GAS f32x4* cdp = nullptr;
        if (cp) { const int pair = u.lin / cper, chunk = u.lin - pair * cper, b = pair & (NB_S - 1);
            const GAS float* sb = (pair >= NB_S ? csrc1 : csrc0) + (size_t)b * cL * 1024 + 8192; GAS float* db = (pair >= NB_S ? cdst1 : cdst0) + (size_t)b * cL * 1024;
            const unsigned tix = (unsigned)chunk * CP_CHUNK + (unsigned)((wr * 4 + wc) * 64 + fq * 16 + fr);
            const GAS f32x4* csp = (const GAS f32x4*)sb + tix; cdp = (GAS f32x4*)db + tix;
#pragma unroll
            for (int k = 0; k < 12; ++k) cv[k] = __builtin_nontemporal_load(csp + k * 512); }
        float ssv[2][4];
#pragma unroll
        for (int ai = 0; ai < 2; ++ai)
#pragma unroll
            for (int m = 0; m < 4; ++m) ssv[ai][m] = ssu[rl0 + ai * 128 + m * 16];
#pragma unroll
        for (int ai = 0; ai < 2; ++ai)
#pragma unroll
            for (int m = 0; m < 4; ++m) {
                const unsigned rl = rl0 + ai * 128 + m * 16;
                const float rs = __builtin_amdgcn_rsqf(ssv[ai][m] * (1.0f / D) + RMS_EPS);
                f32x4 h[2];
#pragma unroll
                for (int n = 0; n < 2; ++n) { const f32x4 a = acc[ai][0][m][n] * rs, b = acc[ai][1][m][n] * rs;
#pragma unroll
                    for (int e = 0; e < 4; ++e) h[n][e] = a[e] * sigmoidf_(a[e]) * b[e]; }
                *(u32x4*)(Ou + (rl * FF + c0)) = pack8(h[0], h[1]);
            }
        if (cp) {
#pragma unroll
            for (int k = 0; k < 12; ++k) __builtin_nontemporal_store(cv[k], cdp + k * 512); }
    }
};
template <bool F32BASE> struct EpiResid {
    static constexpr bool PERM = true;
    const float* base_p; const float* base_s; bf16* xb; float* ssn; float alpha;
    __device__ __forceinline__ void operator()(AccT acc, const Unit& u, int wr, int wc, int fr, int fq) const {
        const size_t uo = (size_t)u.pm * 256 * D + u.pn * 256;
        bf16* xu = xb + uo; float* su = ssn + u.pm * 256;
        unsigned rl0 = wr * 64 + fr, c0 = wc * 32 + 8 * fq; asm volatile("" : "+v"(rl0), "+v"(c0));
        if constexpr (F32BASE) {
            const float* bu = (u.pm < MP / 256) ? base_p + uo : base_s + u.pn * 256;
#pragma unroll
            for (int ai = 0; ai < 2; ++ai) {
                f32x4 bv[4][2][2];
#pragma unroll
                for (int m = 0; m < 4; ++m)
#pragma unroll
                    for (int bj = 0; bj < 2; ++bj) { const unsigned ro = (rl0 + ai * 128 + m * 16) * D + c0 + bj * 128; bv[m][bj][0] = *(const f32x4*)(bu + ro); bv[m][bj][1] = *(const f32x4*)(bu + (ro + 4)); }
#pragma unroll
                for (int m = 0; m < 4; ++m) {
                    const unsigned rl = rl0 + ai * 128 + m * 16; const unsigned ro = rl * D + c0;
                    float sq = 0.f;
#pragma unroll
                    for (int bj = 0; bj < 2; ++bj) {
                        const f32x4 h0 = bv[m][bj][0] + acc[ai][bj][m][0] * alpha, h1 = bv[m][bj][1] + acc[ai][bj][m][1] * alpha;
                        *(u32x4*)(xu + (ro + bj * 128)) = pack8(h0, h1);
                        sq += (h0[0] * h0[0] + h0[1] * h0[1]) + (h0[2] * h0[2] + h0[3] * h0[3]) + (h1[0] * h1[0] + h1[1] * h1[1]) + (h1[2] * h1[2] + h1[3] * h1[3]);
                    }
                    sq += __shfl_xor(sq, 16); sq += __shfl_xor(sq, 32);
                    if (fq == 0) atomicAdd(su + rl, sq);
                }
            }
        } else {
            u32x4 bv[2][4][2];
#pragma unroll
            for (int ai = 0; ai < 2; ++ai)
#pragma unroll
                for (int m = 0; m < 4; ++m)
#pragma unroll
                    for (int bj = 0; bj < 2; ++bj) bv[ai][m][bj] = *(const u32x4*)(xu + ((rl0 + ai * 128 + m * 16) * D + c0 + bj * 128));
#pragma unroll
            for (int ai = 0; ai < 2; ++ai)
#pragma unroll
                for (int m = 0; m < 4; ++m) {
                    const unsigned rl = rl0 + ai * 128 + m * 16; const unsigned ro = rl * D + c0;
                    float sq = 0.f;
#pragma unroll
                    for (int bj = 0; bj < 2; ++bj) {
                        f32x4 b0, b1; unpack8(bv[ai][m][bj], b0, b1);
                        const f32x4 h0 = b0 + acc[ai][bj][m][0] * alpha, h1 = b1 + acc[ai][bj][m][1] * alpha;
                        *(u32x4*)(xu + (ro + bj * 128)) = pack8(h0, h1);
                        sq += (h0[0] * h0[0] + h0[1] * h0[1]) + (h0[2] * h0[2] + h0[3] * h0[3]) + (h1[0] * h1[0] + h1[1] * h1[1]) + (h1[2] * h1[2] + h1[3] * h1[3]);
                    }
                    sq += __shfl_xor(sq, 16); sq += __shfl_xor(sq, 32);
                    if (fq == 0) atomicAdd(su + rl, sq);
                }
        }
    }
};
struct EpiWin {
    static constexpr bool PERM = true;
    unsigned char* ws; const float* ss; const float* qn; const float* kn; float* dout; LAS float* xch;
    __device__ __forceinline__ void operator()(AccT acc, const Unit& u, int wr, int wc, int fr, int fq) const {
        const int pn = u.pn, pm = u.pm; unsigned rl0 = wr * 64 + fr, cw = wc * 32 + 8 * fq; asm volatile("" : "+v"(rl0), "+v"(cw));
        const float* ssu = ss + pm * 256;
        const bool samp = pm >= MP / 256; const int pb = pm >> 3, t0 = (pm & 7) * 256;
        if (pn < 4) {
            bf16* Zu = (bf16*)(ws + WS_ZB) + (size_t)pm * 256 * PW + pn * 256;
            float* so = samp ? dout + O_SPS + 7 * PW + pn * 256 : dout + O_SPP + ((size_t)pb * 15 + t0) * PW - (size_t)(T_P - 15) * PW + pn * 256;
#pragma unroll
            for (int ai = 0; ai < 2; ++ai)
#pragma unroll
                for (int m = 0; m < 4; ++m) {
                    const unsigned rl = rl0 + ai * 128 + m * 16; const float rs = __builtin_amdgcn_rsqf(ssu[rl] * (1.0f / D) + RMS_EPS);
                    const bool keep = samp || (t0 + (int)rl >= T_P - 15);
                    const unsigned sofs = samp ? ((rl >> 3) * 15 + (rl & 7)) * PW + cw : rl * PW + cw;
#pragma unroll
                    for (int bj = 0; bj < 2; ++bj) {
                        const f32x4 v0 = acc[ai][bj][m][0] * rs, v1 = acc[ai][bj][m][1] * rs;
                        *(u32x4*)(Zu + (rl * PW + bj * 128 + cw)) = pack8(v0, v1);
                        if (keep) { *(f32x4*)(so + (sofs + bj * 128)) = v0; *(f32x4*)(so + (sofs + bj * 128 + 4)) = v1; } }
                }
        } else if (pn < 28) {
            const bool isk = pn >= 16; const int hh0 = 2 * (isk ? pn - 16 : pn - 4);
            const float* gn = isk ? kn : qn;
            const f32x4 g0 = *(const f32x4*)(gn + cw), g1 = *(const f32x4*)(gn + cw + 4);
            float rsv[2][4];
#pragma unroll
            for (int ai = 0; ai < 2; ++ai)
#pragma unroll
                for (int m = 0; m < 4; ++m) {
                    const unsigned rl = rl0 + ai * 128 + m * 16; const float rs = __builtin_amdgcn_rsqf(ssu[rl] * (1.0f / D) + RMS_EPS); rsv[ai][m] = rs;
#pragma unroll
                    for (int bj = 0; bj < 2; ++bj) { const f32x4 v0 = acc[ai][bj][m][0] * rs, v1 = acc[ai][bj][m][1] * rs;
                        float sq = (v0[0] * v0[0] + v0[1] * v0[1]) + (v0[2] * v0[2] + v0[3] * v0[3]) + (v1[0] * v1[0] + v1[1] * v1[1]) + (v1[2] * v1[2] + v1[3] * v1[3]);
                        sq += __shfl_xor(sq, 16); sq += __shfl_xor(sq, 32);
                        if (fq == 0) xch[(rl * 2 + bj) * 4 + wc] = sq; }
                }
            asm volatile("s_waitcnt lgkmcnt(0)" ::: "memory"); __builtin_amdgcn_s_barrier(); asm volatile("" ::: "memory");
            bf16* Ou = (bf16*)(ws + (isk ? WS_KB : WS_QB)) + (size_t)pm * 256 * QKVW + hh0 * HD;
            const int g = hh0 >> 3, h0 = hh0 & 7; const int keepn = (g == 0) ? 128 : (g == 1 ? 512 : 2048);
            float* co = samp ? dout + (g == 0 ? O_K0S : (g == 1 ? O_K1S : O_K2S)) + ((size_t)(keepn - 8) * 8 + h0) * HD
                             : dout + (g == 0 ? O_K0P : (g == 1 ? O_K1P : O_K2P)) + (((size_t)pb * keepn + t0) * 8 + h0) * HD - (size_t)(T_P - keepn) * 8 * HD;
#pragma unroll
            for (int ai = 0; ai < 2; ++ai)
#pragma unroll
                for (int m = 0; m < 4; ++m) {
                    const unsigned rl = rl0 + ai * 128 + m * 16; const float rs = rsv[ai][m];
                    const bool keep = isk && (samp || (t0 + (int)rl >= T_P - keepn));
                    const unsigned cofs = samp ? ((rl >> 3) * keepn + (rl & 7)) * 1024 + cw : rl * 1024 + cw;
#pragma unroll
                    for (int bj = 0; bj < 2; ++bj) {
                        const f32x4 pz = *(const LAS f32x4*)(xch + (rl * 2 + bj) * 4);
                        const float rn = rs * __builtin_amdgcn_rsqf(((pz[0] + pz[1]) + (pz[2] + pz[3])) * (1.0f / HD) + RMS_EPS);
                        const f32x4 v0 = acc[ai][bj][m][0] * rn * g0, v1 = acc[ai][bj][m][1] * rn * g1;
                        *(u32x4*)(Ou + (rl * QKVW + bj * HD + cw)) = pack8(v0, v1);
                        if (keep) { *(f32x4*)(co + (cofs + bj * HD)) = v0; *(f32x4*)(co + (cofs + bj * HD + 4)) = v1; }
                    }
                }
        } else if (pn < 40) {
            const int hh0 = 2 * (pn - 28);
            bf16* Ou = (bf16*)(ws + WS_VB) + (size_t)pm * 256 * QKVW + hh0 * HD;
            const int g = hh0 >> 3, h0 = hh0 & 7; const int keepn = (g == 0) ? 128 : (g == 1 ? 512 : 2048);
            float* co = samp ? dout + (g == 0 ? O_V0S : (g == 1 ? O_V1S : O_V2S)) + ((size_t)(keepn - 8) * 8 + h0) * HD
                             : dout + (g == 0 ? O_V0P : (g == 1 ? O_V1P : O_V2P)) + (((size_t)pb * keepn + t0) * 8 + h0) * HD - (size_t)(T_P - keepn) * 8 * HD;
#pragma unroll
            for (int ai = 0; ai < 2; ++ai)
#pragma unroll
                for (int m = 0; m < 4; ++m) {
                    const unsigned rl = rl0 + ai * 128 + m * 16; const float rs = __builtin_amdgcn_rsqf(ssu[rl] * (1.0f / D) + RMS_EPS);
                    const bool keep = samp || (t0 + (int)rl >= T_P - keepn);
                    const unsigned cofs = samp ? ((rl >> 3) * keepn + (rl & 7)) * 1024 + cw : rl * 1024 + cw;
#pragma unroll
                    for (int bj = 0; bj < 2; ++bj) {
                        const f32x4 v0 = acc[ai][bj][m][0] * rs, v1 = acc[ai][bj][m][1] * rs;
                        *(u32x4*)(Ou + (rl * QKVW + bj * HD + cw)) = pack8(v0, v1);
                        if (keep) { *(f32x4*)(co + (cofs + bj * HD)) = v0; *(f32x4*)(co + (cofs + bj * HD + 4)) = v1; }
                    }
                }
        } else {
            bf16* Gu = (bf16*)(ws + WS_GB) + (size_t)pm * 256 * 4096 + (pn - 40) * 256;
#pragma unroll
            for (int ai = 0; ai < 2; ++ai)
#pragma unroll
                for (int m = 0; m < 4; ++m) {
                    const unsigned rl = rl0 + ai * 128 + m * 16; const float rs = __builtin_amdgcn_rsqf(ssu[rl] * (1.0f / D) + RMS_EPS);
#pragma unroll
                    for (int bj = 0; bj < 2; ++bj) {
                        f32x4 v0 = acc[ai][bj][m][0] * rs, v1 = acc[ai][bj][m][1] * rs;
#pragma unroll
                        for (int e = 0; e < 4; ++e) { v0[e] = sigmoidf_(v0[e]); v1[e] = sigmoidf_(v1[e]); }
                        *(u32x4*)(Gu + (rl * 4096 + bj * 128 + cw)) = pack8(v0, v1); }
                }
        }
    }
};
struct EpiScaleCol {
    static constexpr bool PERM = true;
    bf16* O; int ldc; const float* scale;
    __device__ __forceinline__ void operator()(AccT acc, const Unit& u, int wr, int wc, int fr, int fq) const {
        bf16* Ou = O + (size_t)u.pm * 256 * ldc + u.pn * 256;
        unsigned rl0 = wr * 64 + fr, c0 = wc * 32 + 8 * fq; asm volatile("" : "+v"(rl0), "+v"(c0));
        f32x4 s[2][2];
#pragma unroll
        for (int bj = 0; bj < 2; ++bj)
#pragma unroll
            for (int n = 0; n < 2; ++n) s[bj][n] = scale ? *(const f32x4*)(scale + u.pn * 256 + (c0 + bj * 128 + 4 * n)) : (f32x4){1.f, 1.f, 1.f, 1.f};
#pragma unroll
        for (int ai = 0; ai < 2; ++ai)
#pragma unroll
            for (int m = 0; m < 4; ++m) { const unsigned rl = rl0 + ai * 128 + m * 16;
#pragma unroll
                for (int bj = 0; bj < 2; ++bj) *(u32x4*)(Ou + (rl * (unsigned)ldc + c0 + bj * 128)) = pack8(acc[ai][bj][m][0] * s[bj][0], acc[ai][bj][m][1] * s[bj][1]); }
    }
};
template <bool ADD> struct EpiGate {
    static constexpr bool PERM = true;
    bf16* MBp; const bf16* GBp; int goff;
    __device__ __forceinline__ void operator()(AccT acc, const Unit& u, int wr, int wc, int fr, int fq) const {
        bf16* Mu = MBp + (size_t)u.pm * 256 * D + u.pn * 256; const bf16* Gu = GBp + (size_t)u.pm * 256 * 4096 + goff + u.pn * 256;
        unsigned rl0 = wr * 64 + fr, c0 = wc * 32 + 8 * fq; asm volatile("" : "+v"(rl0), "+v"(c0));
#pragma unroll
        for (int ai = 0; ai < 2; ++ai) {
            u32x4 gv[4][2], mv[4][2];
#pragma unroll
            for (int m = 0; m < 4; ++m)
#pragma unroll
                for (int bj = 0; bj < 2; ++bj) { const unsigned rl = rl0 + ai * 128 + m * 16; gv[m][bj] = *(const u32x4*)(Gu + (rl * 4096 + c0 + bj * 128));
                    if (ADD) mv[m][bj] = *(const u32x4*)(Mu + (rl * D + c0 + bj * 128)); }
#pragma unroll
            for (int m = 0; m < 4; ++m) { const unsigned rl = rl0 + ai * 128 + m * 16;
#pragma unroll
                for (int bj = 0; bj < 2; ++bj) {
                    f32x4 g0, g1; unpack8(gv[m][bj], g0, g1);
                    f32x4 r0 = g0 * acc[ai][bj][m][0], r1 = g1 * acc[ai][bj][m][1];
                    if (ADD) { f32x4 p0, p1; unpack8(mv[m][bj], p0, p1); r0 += p0; r1 += p1; }
                    *(u32x4*)(Mu + (rl * D + c0 + bj * 128)) = pack8(r0, r1); } }
        }
    }
};
struct EpiFinal {
    static constexpr bool PERM = true;
    float* out; const bf16* xb; const bf16* PPp; const float* ss;
    __device__ __forceinline__ void operator()(AccT acc, const Unit& u, int wr, int wc, int fr, int fq) const {
        const size_t uo = (size_t)u.pm * 256 * D + u.pn * 256; float* ou = out + uo; const bf16* xu = xb + uo; const bf16* pu = PPp + uo; const float* ssu = ss + u.pm * 256;
        unsigned rl0 = wr * 64 + fr, c0 = wc * 32 + 8 * fq; asm volatile("" : "+v"(rl0), "+v"(c0));
#pragma unroll
        for (int ai = 0; ai < 2; ++ai) {
            u32x4 pv[4][2], hv[4][2]; float ssv[4];
#pragma unroll
            for (int m = 0; m < 4; ++m) { ssv[m] = ssu[rl0 + ai * 128 + m * 16];
#pragma unroll
                for (int bj = 0; bj < 2; ++bj) { const unsigned o = (rl0 + ai * 128 + m * 16) * D + c0 + bj * 128; pv[m][bj] = *(const u32x4*)(pu + o); hv[m][bj] = *(const u32x4*)(xu + o); } }
#pragma unroll
            for (int m = 0; m < 4; ++m) { const float rs = __builtin_amdgcn_rsqf(ssv[m] * (1.0f / D) + RMS_EPS);
#pragma unroll
                for (int bj = 0; bj < 2; ++bj) { const unsigned o = (rl0 + ai * 128 + m * 16) * D + c0 + bj * 128;
                    f32x4 p0, p1, h0, h1; unpack8(pv[m][bj], p0, p1); unpack8(hv[m][bj], h0, h1);
                    const f32x4 a0 = acc[ai][bj][m][0] * rs, a1 = acc[ai][bj][m][1] * rs;
#pragma unroll
                    for (int e = 0; e < 4; ++e) { h0[e] += sigmoidf_(a0[e]) * p0[e]; h1[e] += sigmoidf_(a1[e]) * p1[e]; }
                    *(f32x4*)(ou + o) = h0; *(f32x4*)(ou + (o + 4)) = h1; } }
        }
    }
};

struct Frame {
    LAS unsigned char* lds; volatile LAS unsigned* MISC; gu32* ctl;
    int tid, lane, wave, G, gw, NGW;
    unsigned char* ws; float* out;
};
struct Args { const float* in[29]; float* out; unsigned char* ws; int ph_lo, ph_hi, li, pad; };
enum { I_XP = 0, I_XS, I_PP, I_PS, I_SPOOL, I_CK0, I_CV0, I_CK1, I_CV1, I_CK2, I_CV2, I_F1N, I_F1WI, I_F1WO, I_MIXN, I_WIN, I_QN, I_KN, I_PMAP, I_PSCALE, I_WPO, I_WAO, I_WO,
       I_F2N, I_F2WI, I_F2WO, I_PLEN, I_PLEG, I_PLEP };

template <class T> __device__ __forceinline__ T* opaque_ptr(T* p) { size_t z = 0; asm volatile("" : "+s"(z)); return (T*)((unsigned char*)p + z); }
__device__ __forceinline__ float wave_sum(float v) {
#pragma unroll
    for (int o = 1; o < 64; o <<= 1) v += __shfl_xor(v, o);
    return v;
}
__device__ __forceinline__ float wave_max(float v) {
#pragma unroll
    for (int o = 1; o < 64; o <<= 1) v = fmaxf(v, __shfl_xor(v, o));
    return v;
}
template <int MODE>
__device__ __forceinline__ void transpose_item(const float* W, int K, int N, bf16* WT, const float* gain, LAS float* scr, int item, int lane) {
    const int nblk = N / 32, kb = item / nblk, nb = item % nblk, k0 = 64 * kb, n0 = 32 * nb;
    float wv[32];
#pragma unroll
    for (int i = 0; i < 32; ++i) { const int kk = 2 * i + (lane >> 5); wv[i] = W[(size_t)(k0 + kk) * N + n0 + (lane & 31)]; }
    if (gain) {
#pragma unroll
        for (int i = 0; i < 32; ++i) wv[i] *= gain[k0 + 2 * i + (lane >> 5)]; }
#pragma unroll
    for (int i = 0; i < 32; ++i) scr[(2 * i + (lane >> 5)) * 33 + (lane & 31)] = wv[i];
    LDS_WAIT(); asm volatile("" ::: "memory");
    const int c = lane & 7;
    int r0 = n0;
    if (MODE == 1) { const int isb = n0 >= FF ? 1 : 0, j = n0 - isb * FF; r0 = 256 * (j >> 7) + 128 * isb + (j & 127); }
#pragma unroll
    for (int j = 0; j < 4; ++j) { const int n = (lane >> 3) + 8 * j; const LAS float* s = scr + (8 * c) * 33 + n;
        v4u o; o.x = pk2(s[0 * 33], s[1 * 33]); o.y = pk2(s[2 * 33], s[3 * 33]); o.z = pk2(s[4 * 33], s[5 * 33]); o.w = pk2(s[6 * 33], s[7 * 33]);
        *(GAS v4u*)(WT + (size_t)(r0 + n) * K + k0 + 8 * c) = o; }
    LDS_WAIT(); asm volatile("" ::: "memory");
}

__device__ __forceinline__ void p0_prologue(Frame& F, const Args& a) {
    LAS float* scr = (LAS float*)(F.lds + RING_OFF + F.wave * 16384);
    unsigned char* ws = opaque_ptr(F.ws); float* const dout = opaque_ptr(F.out);
    {
        const int n1 = (D / 64) * (2 * FF / 32), n2 = (FF / 64) * (D / 32), n3 = (D / 64) * (INW / 32), n4 = 4 * (256 / 64) * (256 / 32), n5 = (PW / 64) * (D / 32), n6 = n5,
                  n7 = (D / 64) * (D / 32), n8 = n1, n9 = n2, n10 = n7, n11 = (DPLE / 64) * (D / 32);
        const int total = n1 + n2 + n3 + n4 + n5 + n6 + n7 + n8 + n9 + n10 + n11;
        for (int it = F.gw; it < total; it += F.NGW) {
            int r = it;
            if (r < n1) { transpose_item<1>(a.in[I_F1WI], D, 2 * FF, (bf16*)(ws + WS_W1T), a.in[I_F1N], scr, r, F.lane); continue; } r -= n1;
            if (r < n2) { transpose_item<0>(a.in[I_F1WO], FF, D, (bf16*)(ws + WS_W2T), nullptr, scr, r, F.lane); continue; } r -= n2;
            if (r < n3) { transpose_item<0>(a.in[I_WIN], D, INW, (bf16*)(ws + WS_WINT), a.in[I_MIXN], scr, r, F.lane); continue; } r -= n3;
            if (r < n4) { const int g = r / 32, rr = r % 32; transpose_item<0>(a.in[I_PMAP] + (size_t)g * 65536, 256, 256, (bf16*)(ws + WS_PMT) + (size_t)g * 65536, nullptr, scr, rr, F.lane); continue; } r -= n4;
            if (r < n5) { transpose_item<0>(a.in[I_WPO], PW, D, (bf16*)(ws + WS_WPOT), nullptr, scr, r, F.lane); continue; } r -= n5;
            if (r < n6) { transpose_item<0>(a.in[I_WAO], PW, D, (bf16*)(ws + WS_WAOT), nullptr, scr, r, F.lane); continue; } r -= n6;
            if (r < n7) { transpose_item<0>(a.in[I_WO], D, D, (bf16*)(ws + WS_WOT), nullptr, scr, r, F.lane); continue; } r -= n7;
            if (r < n8) { transpose_item<1>(a.in[I_F2WI], D, 2 * FF, (bf16*)(ws + WS_W3T), a.in[I_F2N], scr, r, F.lane); continue; } r -= n8;
            if (r < n9) { transpose_item<0>(a.in[I_F2WO], FF, D, (bf16*)(ws + WS_W4T), nullptr, scr, r, F.lane); continue; } r -= n9;
            if (r < n10) { transpose_item<0>(a.in[I_PLEG], D, D, (bf16*)(ws + WS_PGT), a.in[I_PLEN], scr, r, F.lane); continue; } r -= n10;
            transpose_item<0>(a.in[I_PLEP], DPLE, D, (bf16*)(ws + WS_PPT), nullptr, scr, r, F.lane);
        }
    }
    {
        bf16* XB = (bf16*)(ws + WS_XB); float* ss0 = (float*)(ws + WS_SS0); bf16* PB = (bf16*)(ws + WS_PB);
        for (int m = F.gw; m < M; m += F.NGW) {
            const float* xr = (m < MP) ? a.in[I_XP] + (size_t)m * D : a.in[I_XS] + (size_t)(m - MP) * D;
            const GAS f32x4* xv = (const GAS f32x4*)xr + F.lane;
            f32x4 v[8]; float s = 0.f;
#pragma unroll
            for (int j = 0; j < 8; ++j) { v[j] = xv[64 * j]; s += (v[j].x * v[j].x + v[j].y * v[j].y) + (v[j].z * v[j].z + v[j].w * v[j].w); }
            s = wave_sum(s);
            GAS v2u* o8 = (GAS v2u*)(XB + (size_t)m * D) + F.lane;
#pragma unroll
            for (int j = 0; j < 8; ++j) { v2u w; w.x = pk2(v[j].x, v[j].y); w.y = pk2(v[j].z, v[j].w); o8[64 * j] = w; }
            if (F.lane == 0) ss0[m] = s;
            const float* pr = (m < MP) ? a.in[I_PP] + (size_t)m * DPLE : a.in[I_PS] + (size_t)(m - MP) * DPLE;
            const f32x4 pv = ((const GAS f32x4*)pr)[F.lane];
            v2u w; w.x = pk2(pv.x, pv.y); w.y = pk2(pv.z, pv.w); ((GAS v2u*)(PB + (size_t)m * DPLE))[F.lane] = w;
        }
    }
    {
        const unsigned gt = blockIdx.x * 512u + (unsigned)F.tid, NT = (unsigned)F.G * 512u;
#pragma unroll 1
        for (int c = 0; c < 2; ++c) {
            const int g = c >> 1; const int L = (g == 0) ? 128 : (g == 1 ? 512 : 2048);
            const float* src = a.in[I_CK0 + c];
            float* dst = dout + ((c == 0) ? O_K0S : (c == 1) ? O_V0S : (c == 2) ? O_K1S : (c == 3) ? O_V1S : (c == 4) ? O_K2S : O_V2S);
            const unsigned per_b = (unsigned)(L - 8) * 256u;
#pragma unroll 1
            for (int b = 0; b < NB_S; ++b) {
                const f32x4* sp = (const f32x4*)(src + (size_t)b * L * 1024 + 8192); f32x4* dp = (f32x4*)(dst + (size_t)b * L * 1024);
                for (unsigned r = gt; r < per_b; r += 8u * NT) { f32x4 v[8];
#pragma unroll
                    for (int k = 0; k < 8; ++k) if (r + k * NT < per_b) v[k] = __builtin_nontemporal_load(sp + (r + k * NT));
#pragma unroll
                    for (int k = 0; k < 8; ++k) if (r + k * NT < per_b) __builtin_nontemporal_store(v[k], dp + (r + k * NT)); }
            }
        }
        const unsigned total = (unsigned)NB_S * 7u * 256u;
        for (unsigned i = gt; i < total; i += NT) { const unsigned b = i / (7u * 256u), r = i - b * (7u * 256u);
            ((f32x4*)(dout + O_SPS + (size_t)b * 15 * 1024))[r] = ((const f32x4*)(a.in[I_SPOOL] + (size_t)b * 15 * 1024 + 8 * 1024))[r]; }
    }
}

__device__ __forceinline__ void pooling_phase(Frame& F, const Args& a) {
    unsigned char* ws = opaque_ptr(F.ws);
    const bf16* ZB = (const bf16*)(ws + WS_ZB); bf16* PO = (bf16*)((unsigned char*)opaque_ptr(F.out) + DO_POOLED);
    const unsigned gt = blockIdx.x * 512u + (unsigned)F.tid, NT = (unsigned)F.G * 512u;
    for (unsigned task = gt; task < (unsigned)(NB_P * (T_P / 32) * 128); task += NT) {
        const unsigned c8 = task & 127, seg = (task >> 7) & 63, b = task >> 13; const unsigned col = c8 * 8; const int w = 2 << (c8 >> 5);
        const int t0 = (int)seg * 32; const bf16* zb = ZB + ((size_t)b * T_P) * PW + col; bf16* pb = PO + ((size_t)b * T_P) * PW + col;
        float s[8];
#pragma unroll
        for (int e = 0; e < 8; ++e) s[e] = 0.f;
        {
            u32x4 pre[16];
#pragma unroll
            for (int j = 0; j < 16; ++j) { const int t = t0 - 1 - j; pre[j] = (j < w && t >= 0) ? *(const u32x4*)(zb + (unsigned)t * PW) : (u32x4){0u, 0u, 0u, 0u}; }
#pragma unroll
            for (int j = 0; j < 16; ++j) { f32x4 a0, a1; unpack8(pre[j], a0, a1);
#pragma unroll
                for (int e = 0; e < 4; ++e) { s[e] += a0[e]; s[4 + e] += a1[e]; } }
        }
#pragma unroll 1
        for (int tt = 0; tt < 32; tt += 8) {
            u32x4 nw[8], od[8];
#pragma unroll
            for (int k = 0; k < 8; ++k) { const int t = t0 + tt + k; nw[k] = *(const u32x4*)(zb + (unsigned)t * PW); od[k] = (t - w >= 0) ? *(const u32x4*)(zb + (unsigned)(t - w) * PW) : (u32x4){0u, 0u, 0u, 0u}; }
#pragma unroll
            for (int k = 0; k < 8; ++k) { const int t = t0 + tt + k; f32x4 n0, n1, o0, o1; unpack8(nw[k], n0, n1); unpack8(od[k], o0, o1);
                const float ic = 1.0f / (float)((t + 1 < w) ? t + 1 : w);
                f32x4 r0, r1;
#pragma unroll
                for (int e = 0; e < 4; ++e) { s[e] += n0[e] - o0[e]; s[4 + e] += n1[e] - o1[e]; r0[e] = s[e] * ic - n0[e]; r1[e] = s[4 + e] * ic - n1[e]; }
                *(u32x4*)(pb + (unsigned)t * PW) = pack8(r0, r1); }
        }
    }
    for (unsigned idx = gt; idx < (unsigned)(MS * 128); idx += NT) {
        const int r = (int)(idx >> 7), c8 = (int)(idx & 127), col = c8 * 8, row = MP + r, b = r >> 3, i = r & 7;
        const int w = 2 << (c8 >> 5);
        float s[8];
#pragma unroll
        for (int e = 0; e < 8; ++e) s[e] = 0.f;
        f32x4 z0, z1; unpack8(*(const u32x4*)(ZB + (size_t)row * PW + col), z0, z1);
        for (int j = 0; j < w; ++j) { const int e_ = 15 + i - j;
            f32x4 a0, a1;
            if (e_ >= 15) unpack8(*(const u32x4*)(ZB + (size_t)(MP + b * 8 + (e_ - 15)) * PW + col), a0, a1);
            else { const float* sp = a.in[I_SPOOL] + ((size_t)b * 15 + e_) * PW + col; a0 = *(const f32x4*)sp; a1 = *(const f32x4*)(sp + 4); }
#pragma unroll
            for (int e = 0; e < 4; ++e) { s[e] += a0[e]; s[4 + e] += a1[e]; } }
        const float ic = 1.0f / (float)w;
        f32x4 o0, o1;
#pragma unroll
        for (int e = 0; e < 4; ++e) { o0[e] = s[e] * ic - z0[e]; o1[e] = s[4 + e] * ic - z1[e]; }
        *(u32x4*)(PO + (size_t)row * PW + col) = pack8(o0, o1);
    }
}

__device__ __forceinline__ void merge_phase(Frame& F) {
    unsigned char* ws = opaque_ptr(F.ws);
    const bf16* OG = (const bf16*)(ws + WS_QB); const float* LSE = (const float*)(ws + WS_LSE); bf16* OA = (bf16*)(ws + WS_OATT);
    const size_t gt = (size_t)blockIdx.x * 512 + F.tid, NT = (size_t)F.G * 512;
    const size_t total = (size_t)M * 128;
    for (size_t idx = gt; idx < total; idx += NT) {
        const int row = (int)(idx >> 7), c8 = (int)(idx & 127), h = c8 >> 4, col = c8 * 8;
        const float l0 = LSE[(size_t)row * 24 + h], l1 = LSE[(size_t)row * 24 + 8 + h], l2 = LSE[(size_t)row * 24 + 16 + h];
        const float mx = fmaxf(l0, fmaxf(l1, l2));
        float w0 = __expf(l0 - mx), w1 = __expf(l1 - mx), w2 = __expf(l2 - mx); const float inv = 1.0f / (w0 + w1 + w2); w0 *= inv; w1 *= inv; w2 *= inv;
        f32x4 a0, a1, b0, b1, c0, c1;
        unpack8(*(const u32x4*)(OG + (size_t)row * QKVW + col), a0, a1);
        unpack8(*(const u32x4*)(OG + (size_t)row * QKVW + 1024 + col), b0, b1);
        unpack8(*(const u32x4*)(OG + (size_t)row * QKVW + 2048 + col), c0, c1);
        *(u32x4*)(OA + (size_t)row * PW + col) = pack8(a0 * w0 + b0 * w1 + c0 * w2, a1 * w0 + b1 * w1 + c1 * w2);
    }
}

__device__ __forceinline__ void sample_attn_phase(Frame& F, const Args& a) {
    unsigned char* ws = opaque_ptr(F.ws); float* const dout = opaque_ptr(F.out);
    bf16* QB = (bf16*)(ws + WS_QB); float* LSE = (float*)(ws + WS_LSE);
    const int lane = F.lane;
#pragma unroll 1
    for (int task = F.gw; task < NB_S * T_S * 24; task += F.NGW) {
        const int hh = task % 24, bi = task / 24, b = bi >> 3, i = bi & 7, g = hh >> 3, h = hh & 7;
        const int row = MP + bi;
        const int dil = 1 << (2 * g), L = 128 << (2 * g);
        const float* ck = a.in[I_CK0 + 2 * g]; const float* cv = a.in[I_CV0 + 2 * g];
        const size_t no = (g == 0 ? O_K0S : (g == 1 ? O_K1S : O_K2S)); const size_t vo_ = (g == 0 ? O_V0S : (g == 1 ? O_V1S : O_V2S));
        const float* nk = dout + no; const float* nv = dout + vo_;
        bf16* qp = QB + (size_t)row * QKVW + hh * HD + 2 * lane;
        const unsigned qw = *(const unsigned*)qp;
        const float q0 = pg8::bf_lo(qw), q1 = pg8::bf_hi(qw);
        const float slope = __builtin_amdgcn_exp2f(-(float)(h + 1));
        const size_t hb = (size_t)h * HD + 2 * lane;
        float sc0 = -1e30f, sc1 = -1e30f, sc2 = -1e30f;
#pragma unroll 1
        for (int j0 = 0; j0 < 160; j0 += 32) {
            f32x2 kv[32];
#pragma unroll
            for (int jj = 0; jj < 32; ++jj) { const int j = j0 + jj; const int jc = j < 129 ? j : 128; const int e_ = L + i - jc * dil;
                const float* kp = (e_ < L) ? ck + ((size_t)b * L + e_) * 1024 : nk + ((size_t)b * L + (e_ - 8)) * 1024;
                kv[jj] = *(const f32x2*)(kp + hb); }
#pragma unroll
            for (int jj = 0; jj < 32; ++jj) { const int j = j0 + jj;
                float d = wave_sum(kv[jj].x * q0 + kv[jj].y * q1);
                d = d * 0.08838834764831845f - slope * (float)(j * dil);
                if (j < 129 && lane == (j & 63)) { if ((j >> 6) == 0) sc0 = d; else if ((j >> 6) == 1) sc1 = d; else sc2 = d; } }
        }
        const float mx = wave_max(fmaxf(sc0, fmaxf(sc1, sc2)));
        const float p0 = __expf(sc0 - mx), p1 = __expf(sc1 - mx), p2 = __expf(sc2 - mx);
        const float den = wave_sum(p0 + p1 + p2);
        float o0 = 0.f, o1 = 0.f;
#pragma unroll 1
        for (int j0 = 0; j0 < 160; j0 += 32) {
            f32x2 vv[32];
#pragma unroll
            for (int jj = 0; jj < 32; ++jj) { const int j = j0 + jj; const int jc = j < 129 ? j : 128; const int e_ = L + i - jc * dil;
                const float* vp = (e_ < L) ? cv + ((size_t)b * L + e_) * 1024 : nv + ((size_t)b * L + (e_ - 8)) * 1024;
                vv[jj] = *(const f32x2*)(vp + hb); }
#pragma unroll
            for (int jj = 0; jj < 32; ++jj) { const int j = j0 + jj;
                const float psel = (j >> 6) == 0 ? p0 : ((j >> 6) == 1 ? p1 : p2);
                const float pj = (j < 129) ? __shfl(psel, j & 63) : 0.f;
                o0 += pj * vv[jj].x; o1 += pj * vv[jj].y; }
        }
        const float id = 1.0f / den;
        *(unsigned*)qp = pk2(o0 * id, o1 * id);
        if (lane == 0) LSE[(size_t)row * 24 + hh] = mx + __logf(den);
    }
}

__device__ __forceinline__ unsigned off_b(unsigned row, unsigned ch) { return 256u * row + 16u * (ch ^ (((row & 3) << 2) | ((row >> 2) & 3))); }
__device__ __forceinline__ void glds16(const void* gsrc, unsigned lds_dst) { unsigned keep;
    asm volatile("s_mov_b32 %0, m0\n\ts_mov_b32 m0, %2\n\ts_nop 0\n\tglobal_load_lds_dwordx4 %1, off\n\ts_mov_b32 m0, %0" : "=&s"(keep) : "v"(gsrc), "s"(lds_dst) : "memory"); }
struct AttnUnit { int b, hh, h, dsh, cls, blk; };
__device__ __forceinline__ AttnUnit attn_decode(int un) {
    AttnUnit u; const int bgh = un >> 4, sub = un & 15; u.b = bgh / 24; u.hh = bgh % 24; const int g = u.hh >> 3; u.h = u.hh & 7; u.dsh = 2 * g;
    u.cls = sub >> (4 - u.dsh); u.blk = sub & ((16 >> u.dsh) - 1); return u;
}
__device__ __forceinline__ void attn_stage(const bf16* base, LAS unsigned char* slot, const AttnUnit& u, int w, int lane) {
    const size_t rowbase = (size_t)u.b * T_P;
#pragma unroll
    for (int c8 = 0; c8 < 8; ++c8) {
        const int c = w * 8 + c8; const int kr = 4 * c + (lane >> 4); const unsigned lc = (unsigned)(lane & 15) ^ (unsigned)(((lane >> 4) << 2) | (c8 & 3));
        int mk = 128 * (u.blk - 1) + kr; mk = mk < 0 ? 0 : mk;
        const size_t tok = rowbase + ((size_t)mk << u.dsh) + u.cls;
        glds16(base + tok * QKVW + u.hh * HD + 8 * lc, (unsigned)(unsigned long long)(slot + 1024 * c));
    }
}
__device__ __forceinline__ void attn_phase(Frame& F) {
    unsigned char* ws = opaque_ptr(F.ws);
    const bf16* KB = (const bf16*)(ws + WS_KB); const bf16* VB = (const bf16*)(ws + WS_VB); bf16* QB = (bf16*)(ws + WS_QB); float* LSE = (float*)(ws + WS_LSE);
    LAS unsigned char* Kt = F.lds + RING_OFF; LAS unsigned char* Vt = F.lds + RING_OFF + 65536;
    const int lane = F.lane, w = F.wave, i16 = lane & 15, g4 = lane >> 4;
    const int NUNITS = NB_P * 24 * 16;
    const int per = (NUNITS + F.G - 1) / F.G;
    const int u_lo = blockIdx.x * per, u_hi = (u_lo + per < NUNITS) ? u_lo + per : NUNITS;
    if (u_lo >= u_hi) return;
    const int T0 = w >> 1;
    int un = u_lo;
    AttnUnit cu = attn_decode(un);
    __syncthreads();
    attn_stage(KB, Kt, cu, w, lane);
    bf16x8 q0, q1, q2, q3;
#define ATTN_QLOAD(u_) do { const int mq_ = 128 * (u_).blk + 16 * w + i16; const size_t qt_ = (size_t)(u_).b * T_P + ((size_t)mq_ << (u_).dsh) + (u_).cls; \
        const bf16* qa_ = QB + qt_ * QKVW + (u_).hh * HD + 8 * g4; \
        asm volatile("global_load_dwordx4 %0, %4, off\n\tglobal_load_dwordx4 %1, %4, off offset:64\n\tglobal_load_dwordx4 %2, %4, off offset:128\n\tglobal_load_dwordx4 %3, %4, off offset:192" \
                     : "=&v"(q0), "=&v"(q1), "=&v"(q2), "=&v"(q3) : "v"(qa_) : "memory"); } while (0)
    ATTN_QLOAD(cu);
    attn_stage(VB, Vt, cu, w, lane);
    for (;;) {
        const bool has_next = (un + 1 < u_hi);
        const AttnUnit nu = attn_decode(has_next ? un + 1 : un);
        const int blk = cu.blk, h = cu.h, hh = cu.hh; const int dil = 1 << cu.dsh;
        const int mq = 128 * blk + 16 * w + i16; const size_t qtok = (size_t)cu.b * T_P + ((size_t)mq << cu.dsh) + cu.cls;
        asm volatile("s_waitcnt vmcnt(8)" : "+v"(q0), "+v"(q1), "+v"(q2), "+v"(q3) :: "memory"); __builtin_amdgcn_s_barrier(); asm volatile("" ::: "memory");
        const bf16x8 qf[4] = {q0, q1, q2, q3};
        unsigned ka0 = off_b(32u * T0 + 8u * (i16 >> 2) + (i16 & 3), g4);
        asm volatile("" : "+v"(ka0));
        f32x4 S[5][2];
#pragma unroll
        for (int T = 0; T < 5; ++T)
#pragma unroll
            for (int u = 0; u < 2; ++u) {
                S[T][u] = (f32x4){0.f, 0.f, 0.f, 0.f};
#pragma unroll
                for (int ks = 0; ks < 4; ++ks) { const bf16x8 kf = *(const LAS bf16x8*)(Kt + ((ka0 ^ (unsigned)((ks << 6) | (u << 4))) + 1024u * u + 8192u * T));
                    S[T][u] = __builtin_amdgcn_mfma_f32_16x16x32_bf16(kf, qf[ks], S[T][u], 0, 0, 0); }
            }
        asm volatile("" ::: "memory"); __builtin_amdgcn_s_barrier(); asm volatile("" ::: "memory");
        if (has_next) { attn_stage(KB, Kt, nu, w, lane); ATTN_QLOAD(nu); }
        asm volatile("" ::: "memory");
        const float c1 = 0.08838834764831845f * 1.4426950408889634f;
        const float c2 = __builtin_amdgcn_exp2f(-(float)(h + 1)) * (float)dil * 1.4426950408889634f;
        const int qi = 16 * w + i16;
        const int sbase = 128 + qi - 32 * T0 - 8 * g4; const unsigned smax = blk > 0 ? 128u : (unsigned)qi;
        float mx = -1e30f;
#pragma unroll
        for (int T = 0; T < 5; ++T)
#pragma unroll
            for (int u = 0; u < 2; ++u)
#pragma unroll
                for (int r = 0; r < 4; ++r) { const int steps = sbase - (32 * T + 4 * u + r);
                    const bool valid = (unsigned)steps <= smax;
                    const float l = valid ? S[T][u][r] * c1 - c2 * (float)steps : -1e30f; S[T][u][r] = l; mx = fmaxf(mx, l); }
        mx = fmaxf(mx, __shfl_xor(mx, 16)); mx = fmaxf(mx, __shfl_xor(mx, 32));
        float den = 0.f; bf16x8 pf[5];
#pragma unroll
        for (int T = 0; T < 5; ++T) { float p[8];
#pragma unroll
            for (int u = 0; u < 2; ++u)
#pragma unroll
                for (int r = 0; r < 4; ++r) { const float e = __builtin_amdgcn_exp2f(S[T][u][r] - mx); p[4 * u + r] = e; den += e; }
            v4u pw; pw.x = pg8::cvt_pk_bf16(p[0], p[1]); pw.y = pg8::cvt_pk_bf16(p[2], p[3]); pw.z = pg8::cvt_pk_bf16(p[4], p[5]); pw.w = pg8::cvt_pk_bf16(p[6], p[7]);
            pf[T] = __builtin_bit_cast(bf16x8, pw); }
        den += __shfl_xor(den, 16); den += __shfl_xor(den, 32);
        if (has_next) asm volatile("s_waitcnt vmcnt(12)" ::: "memory"); else asm volatile("s_waitcnt vmcnt(0)" ::: "memory");
        __builtin_amdgcn_s_barrier(); asm volatile("" ::: "memory");
        unsigned va0;
        { const unsigned q = (lane & 15) >> 2, p = lane & 3; va0 = off_b(32u * T0 + 8u * g4 + q, (p >> 1)) + 8u * (p & 1); }
        asm volatile("" : "+v"(va0));
        f32x4 O[8];
#pragma unroll
        for (int dt = 0; dt < 8; ++dt) { O[dt] = (f32x4){0.f, 0.f, 0.f, 0.f};
            const unsigned vd = va0 ^ (unsigned)(dt << 5);
#pragma unroll
            for (int T = 0; T < 5; ++T) {
                const s16x4 v0 = __builtin_amdgcn_ds_read_tr16_b64_v4i16((LAS s16x4*)(Vt + (vd + 8192u * T)));
                const s16x4 v1 = __builtin_amdgcn_ds_read_tr16_b64_v4i16((LAS s16x4*)(Vt + ((vd ^ 16u) + 1024u + 8192u * T)));
                const bf16x8 vf = (bf16x8){v0[0], v0[1], v0[2], v0[3], v1[0], v1[1], v1[2], v1[3]};
                O[dt] = __builtin_amdgcn_mfma_f32_16x16x32_bf16(vf, pf[T], O[dt], 0, 0, 0); } }
        asm volatile("" ::: "memory"); __builtin_amdgcn_s_barrier(); asm volatile("" ::: "memory");
        const float id = 1.0f / den;
        bf16* op = QB + qtok * QKVW + hh * HD + 4 * g4;
#pragma unroll
        for (int dt = 0; dt < 8; ++dt) { v2u o; o.x = pg8::cvt_pk_bf16(O[dt][0] * id, O[dt][1] * id); o.y = pg8::cvt_pk_bf16(O[dt][2] * id, O[dt][3] * id); *(v2u*)(op + 16 * dt) = o; }
        if (g4 == 0) LSE[qtok * 24 + hh] = (mx + __builtin_amdgcn_logf(den)) * 0.6931471805599453f;
        asm volatile("" ::: "memory");
        if (!has_next) break;
        attn_stage(VB, Vt, nu, w, lane);
        asm volatile("" ::: "memory");
        cu = nu; ++un;
    }
    asm volatile("s_waitcnt vmcnt(0)" ::: "memory");
    __syncthreads();
#undef ATTN_QLOAD
}

constexpr int N_PHASES = 12;
__global__ void __launch_bounds__(NWAVES * 64, 2) mk_fwd(Args args) {
    extern __shared__ __attribute__((aligned(16))) unsigned char lds[];
    Frame F;
    F.lds = (LAS unsigned char*)lds; F.MISC = (volatile LAS unsigned*)(F.lds + MISC_OFF);
    F.tid = threadIdx.x; F.lane = F.tid & 63; F.wave = __builtin_amdgcn_readfirstlane(F.tid >> 6);
    F.G = gridDim.x; F.gw = blockIdx.x * NWAVES + F.wave; F.NGW = F.G * NWAVES;
    F.ws = args.ws; F.out = args.out; F.ctl = (gu32*)(args.ws + WS_CTL);
    for (int u = F.tid; u < 32; u += NWAVES * 64) ((LAS unsigned*)(F.lds + MISC_OFF))[u] = 0u;
    __syncthreads();
    XcdBarrier bar; bar.bar = (unsigned*)(F.ctl + CW_BAR); bar.x = 0; bar.st = nullptr;
    if (MK_N_LAUNCHES == 1) bar = xcd_barrier_post((unsigned*)(F.ctl + CW_BAR), F.MISC + 8);
#define GRID_BAR() do { if (MK_N_LAUNCHES == 1) xcd_barrier(bar); } while (0)
    const int lo = args.ph_lo, hi = args.ph_hi;
#if defined(PROBE_A)
    volatile LAS unsigned long long* tst = (volatile LAS unsigned long long*)(F.lds + MISC_OFF + 128);
    if (threadIdx.x == 0) tst[0] = __builtin_amdgcn_s_memrealtime();
#define STAMP(k) do { if (threadIdx.x == 0) tst[(k) + 1] = __builtin_amdgcn_s_memrealtime(); } while (0)
#else
#define STAMP(k) do { } while (0)
#endif
#ifndef PHMASK
#define PHMASK 0xFFF
#endif
#define IN(k) (((PHMASK >> (k)) & 1) && lo <= (k) && (k) < hi)
#define BOTH(k) (IN(k) && IN((k) + 1))
    const int cid = (int)blockIdx.x;
#define PHASE_WS unsigned char* const ws = opaque_ptr(args.ws)
#define WSP(T, off) ((T*)(ws + (off)))
#define SS0 ((float*)(ws + WS_SS0))
#define SS1 ((float*)(ws + WS_CTL) + CW_SS1)
#define SS2 ((float*)(ws + WS_CTL) + CW_SS2)
#define SS3 ((float*)(ws + WS_CTL) + CW_SS3)
#define HOUT (args.out + O_Y)

    if (IN(0)) { p0_prologue(F, args); if (BOTH(0)) GRID_BAR(); }
    STAMP(0);
    if (IN(1)) { PHASE_WS; pg8::Gemm g{WSP(const bf16, WS_XB), WSP(const bf16, WS_W1T), M, 2 * FF, D, D, D, 0}; pg8::StaticOrder S; S.init(M, 2 * FF, F.G, cid);
        EpiSwiglu E{WSP(bf16, WS_HID), SS0, (const GAS float*)args.in[I_CK2], (const GAS float*)args.in[I_CV2], (GAS float*)(args.out + O_K2S), (GAS float*)(args.out + O_V2S), CP_PER_PAIR, 2048}; pg8::gemm_phase<EpiSwiglu, pg8::StaticOrder>(F.lds + RING_OFF, g, S, E); if (BOTH(1)) GRID_BAR(); }
    STAMP(1);
    if (IN(2)) { PHASE_WS; pg8::Gemm g{WSP(const bf16, WS_HID), WSP(const bf16, WS_W2T), M, D, FF, FF, FF, 0}; pg8::StaticOrder S; S.init(M, D, F.G, cid, 4);
        EpiResid<true> E{args.in[I_XP], args.in[I_XS], WSP(bf16, WS_XB), SS1, 0.5f}; pg8::gemm_phase<EpiResid<true>, pg8::StaticOrder>(F.lds + RING_OFF, g, S, E); if (BOTH(2)) GRID_BAR(); }
    STAMP(2);
    if (IN(3)) { PHASE_WS; pg8::Gemm g{WSP(const bf16, WS_XB), WSP(const bf16, WS_WINT), M, INW, D, D, D, 0}; pg8::StaticOrder S; S.init(M, INW, F.G, cid);
        EpiWin E{ws, SS1, args.in[I_QN], args.in[I_KN], args.out, (LAS float*)(F.lds + XCH_OFF)};
        pg8::gemm_phase<EpiWin, pg8::StaticOrder>(F.lds + RING_OFF, g, S, E); if (BOTH(3)) GRID_BAR(); }
    STAMP(3);
    if (IN(4)) { PHASE_WS; pooling_phase(F, args); sample_attn_phase(F, args); attn_phase(F); if (BOTH(4)) GRID_BAR(); }
    STAMP(4);
    if (IN(5)) { PHASE_WS; pg8::Gemm g{(const bf16*)((unsigned char*)args.out + DO_POOLED), WSP(const bf16, WS_PMT), M, PW, 256, PW, 256, 256}; pg8::StaticOrder S; S.init(M, PW, F.G, cid);
        EpiScaleCol E{(bf16*)((unsigned char*)args.out + DO_YPOOL), PW, args.in[I_PSCALE]}; pg8::gemm_phase<EpiScaleCol, pg8::StaticOrder>(F.lds + RING_OFF, g, S, E);
        merge_phase(F); if (BOTH(5)) GRID_BAR(); }
    STAMP(5);
    if (IN(6)) { PHASE_WS; pg8::Gemm g{(const bf16*)((unsigned char*)args.out + DO_YPOOL), WSP(const bf16, WS_WPOT), M, D, PW, PW, PW, 0}; pg8::StaticOrder S; S.init(M, D, F.G, cid);
        EpiGate<false> E{WSP(bf16, WS_MB), WSP(const bf16, WS_GB), 0}; pg8::gemm_phase<EpiGate<false>, pg8::StaticOrder>(F.lds + RING_OFF, g, S, E); if (BOTH(6)) GRID_BAR(); }
    STAMP(6);
    if (IN(7)) { PHASE_WS; pg8::Gemm g{WSP(const bf16, WS_OATT), WSP(const bf16, WS_WAOT), M, D, PW, PW, PW, 0}; pg8::StaticOrder S; S.init(M, D, F.G, cid);
        EpiGate<true> E{WSP(bf16, WS_MB), WSP(const bf16, WS_GB), 2048}; pg8::gemm_phase<EpiGate<true>, pg8::StaticOrder>(F.lds + RING_OFF, g, S, E); if (BOTH(7)) GRID_BAR(); }
    STAMP(7);
    if (IN(8)) { PHASE_WS; { pg8::Gemm g{WSP(const bf16, WS_MB), WSP(const bf16, WS_WOT), M, D, D, D, D, 0}; pg8::StaticOrder S; S.init(M, D, F.G, cid);
          EpiResid<false> E{nullptr, nullptr, WSP(bf16, WS_XB), SS2, 1.0f}; pg8::gemm_phase<EpiResid<false>, pg8::StaticOrder>(F.lds + RING_OFF, g, S, E); }
        { pg8::Gemm g{WSP(const bf16, WS_PB), WSP(const bf16, WS_PPT), M, D, DPLE, DPLE, DPLE, 0}; pg8::StaticOrder S; S.init(M, D, F.G, cid);
          EpiScaleCol E{WSP(bf16, WS_PP), D, nullptr}; pg8::gemm_phase<EpiScaleCol, pg8::StaticOrder>(F.lds + RING_OFF, g, S, E); }
        if (BOTH(8)) GRID_BAR(); }
    STAMP(8);
    if (IN(9)) { PHASE_WS; pg8::Gemm g{WSP(const bf16, WS_XB), WSP(const bf16, WS_W3T), M, 2 * FF, D, D, D, 0}; pg8::StaticOrder S; S.init(M, 2 * FF, F.G, cid);
        EpiSwiglu E{WSP(bf16, WS_HID), SS2, (const GAS float*)args.in[I_CK1], (const GAS float*)args.in[I_CV1], (GAS float*)(args.out + O_K1S), (GAS float*)(args.out + O_V1S), 21, 512}; pg8::gemm_phase<EpiSwiglu, pg8::StaticOrder>(F.lds + RING_OFF, g, S, E); if (BOTH(9)) GRID_BAR(); }
    STAMP(9);
    if (IN(10)) { PHASE_WS; pg8::Gemm g{WSP(const bf16, WS_HID), WSP(const bf16, WS_W4T), M, D, FF, FF, FF, 0}; pg8::StaticOrder S; S.init(M, D, F.G, cid, 4);
        EpiResid<false> E{nullptr, nullptr, WSP(bf16, WS_XB), SS3, 0.5f}; pg8::gemm_phase<EpiResid<false>, pg8::StaticOrder>(F.lds + RING_OFF, g, S, E); if (BOTH(10)) GRID_BAR(); }
    STAMP(10);
    if (IN(11)) { PHASE_WS; pg8::Gemm g{WSP(const bf16, WS_XB), WSP(const bf16, WS_PGT), M, D, D, D, D, 0}; pg8::StaticOrder S; S.init(M, D, F.G, cid);
        EpiFinal E{HOUT, WSP(const bf16, WS_XB), WSP(const bf16, WS_PP), SS3}; pg8::gemm_phase<EpiFinal, pg8::StaticOrder>(F.lds + RING_OFF, g, S, E); }
    STAMP(11);
#if defined(PROBE_A)
    if (blockIdx.x == 0 && threadIdx.x == 0) {
        unsigned long long da = tst[PROBE_A + 1] - tst[PROBE_A], db = tst[PROBE_B + 1] - tst[PROBE_B];
        unsigned na = (unsigned)(da / 2500ull), nb = (unsigned)(db / 2500ull); na = na > 63u ? 63u : na; nb = nb > 63u ? 63u : nb;
        const unsigned long long extra = (unsigned long long)(na * 64u + nb) * 10000ull, t0 = __builtin_amdgcn_s_memrealtime();
        while (__builtin_amdgcn_s_memrealtime() - t0 < extra) __builtin_amdgcn_s_sleep(32);
    }
#endif
#undef IN
#undef BOTH
}

extern "C" void kernel_launch(void* const* d_in, const int* in_sizes, int n_in, void* d_out, int out_size, void* d_ws, size_t ws_size, hipStream_t stream) {
    static int grid = 0;
    if (grid == 0) {
        if (n_in != 29 || (size_t)out_size != O_END || ws_size < WS_END) { fprintf(stderr, "kernel_launch: unexpected sizes: n_in %d out %d ws %zu (need %zu)\n", n_in, out_size, ws_size, (size_t)WS_END); grid = -1; return; }
        int dev = 0, cus = 0;
        if (hipGetDevice(&dev) != hipSuccess || hipDeviceGetAttribute(&cus, hipDeviceAttributeMultiprocessorCount, dev) != hipSuccess) { grid = -1; return; }
        if (hipFuncSetAttribute((const void*)mk_fwd, hipFuncAttributeMaxDynamicSharedMemorySize, LDS_BYTES) != hipSuccess) { grid = -1; return; }
        int per_cu = 0;
        (void)hipOccupancyMaxActiveBlocksPerMultiprocessor(&per_cu, (const void*)mk_fwd, NWAVES * 64, LDS_BYTES);
        (void)hipGetLastError();
        grid = cus;
    }
    if (grid < 0) return;
    (void)hipMemsetAsync((char*)d_ws + WS_CTL, 0, CTL_ZERO_BYTES, stream);
    Args a{};
    for (int i = 0; i < 29; ++i) a.in[i] = (const float*)d_in[i];
    a.out = (float*)d_out; a.ws = (unsigned char*)d_ws;
    if (MK_N_LAUNCHES == 1) { a.ph_lo = 0; a.ph_hi = N_PHASES; a.li = 0; hipLaunchKernelGGL(mk_fwd, dim3(grid), dim3(NWAVES * 64), LDS_BYTES, stream, a); }
    else for (int li = 0; li < N_PHASES; ++li) { a.ph_lo = li; a.ph_hi = li + 1; a.li = li; hipLaunchKernelGGL(mk_fwd, dim3(grid), dim3(NWAVES * 64), LDS_BYTES, stream, a); }
}
```
